# Optimizing an MI355X kernel written in HIP

```python
import jax, jax.numpy as jnp
from jax import lax
import numpy as np

D_MODEL = 2048
BATCH = 2
SEQ = 8192
DEPTH = 1
DEC_BATCH = 32
DEC_SEQ = 1
PAST_LEN = 16384
PAGE_SIZE = 128

N_MEM = 256
EPS = 1e-6
ROPE_THETA = 10000.0
NEG = -1e30

GLA_HEADS = 4
GLA_DK = D_MODEL // 16
GLA_DV = D_MODEL // 8
GLA_RANK = 16
GLA_TAU = 16.0
GLA_CHUNK = 64
GLA_KW = GLA_HEADS * GLA_DK
GLA_VW = GLA_HEADS * GLA_DV

SWA_PATTERNS = ((128, 1), (512, 4), (2048, 16))
SWA_GROUPS = 3
SWA_HEADS = 4
SWA_HD = D_MODEL // 16
SWA_W = SWA_HEADS * SWA_HD
SWA_BLK = 128

MEM_HEADS = 4
MEM_HD = D_MODEL // 16
MEM_W = MEM_HEADS * MEM_HD

N_BRANCH = 3
IN_SIZES = (GLA_KW, GLA_KW, GLA_VW, GLA_VW, GLA_RANK,
            SWA_GROUPS * SWA_W, SWA_GROUPS * SWA_W, SWA_GROUPS * SWA_W, SWA_W,
            MEM_W, MEM_W, N_BRANCH * D_MODEL)
IN_TOTAL = 2 * GLA_KW + 2 * GLA_VW + GLA_RANK + 3 * SWA_GROUPS * SWA_W + SWA_W + 2 * MEM_W + N_BRANCH * D_MODEL

kernel_name = "gated_branch_gla_dilated_swa_memory_decoder_step"


def _rmsnorm(x, g):
    xf = x.astype(jnp.float32)
    y = xf * lax.rsqrt(jnp.mean(xf * xf, axis=-1, keepdims=True) + EPS)
    return (y * g.astype(jnp.float32)).astype(x.dtype)


def _heads(t, n_heads, hd):
    return t.reshape(t.shape[0], t.shape[1], n_heads, hd)


def _rope(x, pos):
    half = x.shape[-1] // 2
    inv = ROPE_THETA ** (-jnp.arange(half, dtype=jnp.float32) / half)
    ang = pos.astype(jnp.float32)[:, None] * inv[None, :]
    cos = jnp.cos(ang)[None, :, None, :]
    sin = jnp.sin(ang)[None, :, None, :]
    xf = x.astype(jnp.float32)
    x1, x2 = xf[..., :half], xf[..., half:]
    return jnp.concatenate([x1 * cos - x2 * sin, x2 * cos + x1 * sin], axis=-1).astype(x.dtype)


def _gla(q, k, v, log_a, s0):
    B, L, H, DK = q.shape
    DV = v.shape[-1]
    C = min(GLA_CHUNK, L)
    Lp = -(-L // C) * C
    n = Lp // C
    padw = ((0, 0), (0, Lp - L), (0, 0), (0, 0))

    def chunks(t):
        t = jnp.pad(t.astype(jnp.float32), padw)
        return t.reshape(B, n, C, H, t.shape[-1]).transpose(1, 0, 3, 2, 4)

    qc = chunks(q) * (DK ** -0.5)
    kc, vc, ac = chunks(k), chunks(v), chunks(log_a)
    causal = jnp.tril(jnp.ones((C, C), dtype=bool))[:, :, None]

    def step(S, inp):
        qi, ki, vi, ai = inp
        b = jnp.cumsum(ai, axis=2)
        diff = b[:, :, :, None, :] - b[:, :, None, :, :]
        decay = jnp.exp(jnp.where(causal, diff, -jnp.inf))
        A = jnp.einsum('bhtk,bhsk,bhtsk->bhts', qi, ki, decay)
        o = jnp.einsum('bhts,bhsv->bhtv', A, vi) + jnp.einsum('bhtk,bhkv->bhtv', qi * jnp.exp(b), S)
        b_end = b[:, :, -1:, :]
        S_new = jnp.exp(b_end[:, :, 0, :])[..., None] * S + jnp.einsum('bhsk,bhsv->bhkv', ki * jnp.exp(b_end - b), vi)
        return S_new, o

    S, o = lax.scan(step, s0.astype(jnp.float32), (qc, kc, vc, ac))
    o = o.transpose(1, 0, 3, 2, 4).reshape(B, Lp, H, DV)[:, :L]
    return o, S


def _dilated_prompt(q, k, v, window, dil):
    B, S, H, E = q.shape
    n_keys = window // dil
    blk = SWA_BLK
    unit = dil * blk
    Sp = -(-S // unit) * unit
    nb = Sp // unit
    padw = ((0, 0), (0, Sp - S), (0, 0), (0, 0))

    def split(t):
        t = jnp.pad(t.astype(jnp.float32), padw)
        return t.reshape(B, nb * blk, dil, H, E).transpose(0, 2, 1, 3, 4).reshape(B, dil, nb, blk, H, E)

    def with_prev(t):
        prev = jnp.concatenate([jnp.zeros_like(t[:, :, :1]), t[:, :, :-1]], axis=2)
        return jnp.concatenate([prev, t], axis=3)

    qb = split(q) * (E ** -0.5)
    kk, vv = with_prev(split(k)), with_prev(split(v))
    s = jnp.einsum('brnqhe,brnkhe->brnhqk', qb, kk)
    qi = jnp.arange(blk)[:, None]
    ki = jnp.arange(2 * blk)[None, :]
    delta = blk + qi - ki
    band = (delta >= 0) & (delta <= n_keys)
    valid = band[None] & ((jnp.arange(nb)[:, None, None] > 0) | (ki[None] >= blk))
    s = jnp.where(valid[None, None, :, None], s, NEG)
    m = jnp.max(s, axis=-1, keepdims=True)
    p = jnp.exp(s - m)
    den = jnp.sum(p, axis=-1)
    o = jnp.einsum('brnhqk,brnkhe->brnqhe', p, vv) / den.transpose(0, 1, 2, 4, 3)[..., None]
    lse = (m[..., 0] + jnp.log(den)).transpose(0, 1, 2, 4, 3)
    o = o.reshape(B, dil, nb * blk, H, E).transpose(0, 2, 1, 3, 4).reshape(B, Sp, H, E)[:, :S]
    lse = lse.reshape(B, dil, nb * blk, H).transpose(0, 2, 1, 3).reshape(B, Sp, H)[:, :S]
    return o, lse


def _dilated_step(q, k_new, v_new, buf, window, dil):
    Lb = buf.shape[1]
    L, E = q.shape[1], q.shape[-1]
    n_keys = window // dil
    kv_all = jnp.concatenate([buf, jnp.stack([k_new, v_new], axis=2)], axis=1)
    idx = Lb + jnp.arange(L)[:, None] - dil * jnp.arange(n_keys + 1)[None, :]
    valid = idx >= 0
    g = kv_all[:, jnp.maximum(idx, 0)].astype(jnp.float32)
    s = jnp.einsum('blhe,blmhe->blhm', q.astype(jnp.float32) * (E ** -0.5), g[:, :, :, 0])
    s = jnp.where(valid[None, :, None, :], s, NEG)
    m = jnp.max(s, axis=-1, keepdims=True)
    p = jnp.exp(s - m)
    den = jnp.sum(p, axis=-1)
    o = jnp.einsum('blhm,blmhe->blhe', p, g[:, :, :, 1]) / den[..., None]
    lse = m[..., 0] + jnp.log(den)
    return o, lse, kv_all[:, L:]


def _mem_kv(mem, g_mem, w_mem_kv):
    kv = _rmsnorm(mem, g_mem) @ w_mem_kv
    return kv.reshape(mem.shape[0], mem.shape[1], 2, MEM_HEADS, MEM_HD)


def _layer(x, mem_kv, gla_s0, swa_bufs, pos0, g_norm, w_in, w_alpha2, b_alpha, g_gla_out,
           w_proj_a, w_proj_b, w_proj_c, w_out):
    nbat, L, _ = x.shape
    h = _rmsnorm(x, g_norm)
    z = h @ w_in
    cuts = [int(c) for c in np.cumsum(IN_SIZES)[:-1]]
    gq, gk, gv, gr, ga, sq, sk, sv, sr, mq, mr, gts = jnp.split(z, cuts, axis=-1)

    log_a = jax.nn.log_sigmoid((ga @ w_alpha2 + b_alpha).astype(jnp.float32)) / GLA_TAU
    o_a, gla_s = _gla(_heads(gq, GLA_HEADS, GLA_DK), _heads(gk, GLA_HEADS, GLA_DK),
                      _heads(gv, GLA_HEADS, GLA_DV), _heads(log_a, GLA_HEADS, GLA_DK), gla_s0)
    o_a = _rmsnorm(o_a, g_gla_out.reshape(GLA_HEADS, GLA_DV)).reshape(nbat, L, GLA_VW).astype(x.dtype)
    y_a = (o_a * jax.nn.silu(gr)) @ w_proj_a

    pos = pos0 + jnp.arange(L, dtype=jnp.int32)
    n_sh = SWA_GROUPS * SWA_HEADS
    q_b = _rope(_heads(sq, n_sh, SWA_HD), pos)
    k_b = _rope(_heads(sk, n_sh, SWA_HD), pos)
    v_b = _heads(sv, n_sh, SWA_HD)
    outs, lses, new_bufs = [], [], []
    for gi, (win, dil) in enumerate(SWA_PATTERNS):
        hsl = slice(gi * SWA_HEADS, (gi + 1) * SWA_HEADS)
        qg, kg, vg = q_b[:, :, hsl], k_b[:, :, hsl], v_b[:, :, hsl]
        if swa_bufs is None:
            o, lse = _dilated_prompt(qg, kg, vg, win, dil)
            buf = jnp.stack([kg, vg], axis=2)[:, L - min(win, L):]
        else:
            o, lse, buf = _dilated_step(qg, kg, vg, swa_bufs[gi], win, dil)
        outs.append(o)
        lses.append(lse)
        new_bufs.append(buf)
    w_grp = jax.nn.softmax(jnp.stack(lses, axis=0), axis=0)[..., None]
    o_b = jnp.sum(w_grp * jnp.stack(outs, axis=0), axis=0).reshape(nbat, L, SWA_W).astype(x.dtype)
    y_b = (o_b * jax.nn.silu(sr)) @ w_proj_b

    qm = _heads(mq, MEM_HEADS, MEM_HD).astype(jnp.float32) * (MEM_HD ** -0.5)
    sc = jnp.einsum('blhe,bmhe->bhlm', qm, mem_kv[:, :, 0].astype(jnp.float32))
    pm = jax.nn.softmax(sc, axis=-1)
    o_c = jnp.einsum('bhlm,bmhe->blhe', pm, mem_kv[:, :, 1].astype(jnp.float32)).reshape(nbat, L, MEM_W).astype(x.dtype)
    y_c = (o_c * jax.nn.silu(mr)) @ w_proj_c

    g_a, g_b, g_c = jnp.split(jax.nn.sigmoid(gts), N_BRANCH, axis=-1)
    x = x + (g_a * y_a + g_b * y_b + g_c * y_c) @ w_out
    return x, gla_s, new_bufs


def setup_inputs(seed: int = 0) -> dict:
    key = jax.random.key(seed)
    ks = jax.random.split(key, 24)

    def nrm(k, shape, scale):
        return jax.random.normal(k, shape, jnp.float32) * scale

    swa_len = [min(w, PAST_LEN) for w, _ in SWA_PATTERNS]
    return {
        "x_prompt": nrm(ks[0], (BATCH, SEQ, D_MODEL), 1.0),
        "x_sample": nrm(ks[1], (DEC_BATCH, DEC_SEQ, D_MODEL), 1.0),
        "mem_prompt": nrm(ks[2], (BATCH, N_MEM, D_MODEL), 1.0),
        "state_gla": nrm(ks[3], (DEPTH, DEC_BATCH, GLA_HEADS, GLA_DK, GLA_DV), 0.5),
        "cache_swa_w128": nrm(ks[4], (DEPTH, DEC_BATCH, swa_len[0], 2, SWA_HEADS, SWA_HD), 1.0),
        "cache_swa_w512": nrm(ks[5], (DEPTH, DEC_BATCH, swa_len[1], 2, SWA_HEADS, SWA_HD), 1.0),
        "cache_swa_w2048": nrm(ks[6], (DEPTH, DEC_BATCH, swa_len[2], 2, SWA_HEADS, SWA_HD), 1.0),
        "cache_mem_kv": nrm(ks[7], (DEPTH, DEC_BATCH, N_MEM, 2, MEM_HEADS, MEM_HD), 1.0),
        "g_norm": 1.0 + nrm(ks[8], (DEPTH, D_MODEL), 0.02),
        "w_in": nrm(ks[9], (DEPTH, D_MODEL, IN_TOTAL), D_MODEL ** -0.5),
        "w_alpha2": nrm(ks[10], (DEPTH, GLA_RANK, GLA_KW), GLA_RANK ** -0.5),
        "b_alpha": nrm(ks[11], (DEPTH, GLA_KW), 0.1),
        "g_gla_out": 1.0 + nrm(ks[12], (DEPTH, GLA_VW), 0.02),
        "g_mem": 1.0 + nrm(ks[13], (DEPTH, D_MODEL), 0.02),
        "w_mem_kv": nrm(ks[14], (DEPTH, D_MODEL, 2 * MEM_W), D_MODEL ** -0.5),
        "w_proj_a": nrm(ks[15], (DEPTH, GLA_VW, D_MODEL), GLA_VW ** -0.5),
        "w_proj_b": nrm(ks[16], (DEPTH, SWA_W, D_MODEL), SWA_W ** -0.5),
        "w_proj_c": nrm(ks[17], (DEPTH, MEM_W, D_MODEL), MEM_W ** -0.5),
        "w_out": nrm(ks[18], (DEPTH, D_MODEL, D_MODEL), D_MODEL ** -0.5),
        "g_final": 1.0 + nrm(ks[19], (D_MODEL,), 0.02),
    }


def reference(x_prompt, x_sample, mem_prompt, state_gla, cache_swa_w128, cache_swa_w512, cache_swa_w2048,
              cache_mem_kv, g_norm, w_in, w_alpha2, b_alpha, g_gla_out, g_mem, w_mem_kv, w_proj_a, w_proj_b,
              w_proj_c, w_out, g_final):
    hp, hs = x_prompt, x_sample
    gla_p, gla_s, mem_p = [], [], []
    swa_p = [[], [], []]
    swa_s = [[], [], []]
    for l in range(DEPTH):
        lw = (g_norm[l], w_in[l], w_alpha2[l], b_alpha[l], g_gla_out[l], w_proj_a[l], w_proj_b[l], w_proj_c[l], w_out[l])
        mkv_p = _mem_kv(mem_prompt, g_mem[l], w_mem_kv[l])
        s0 = jnp.zeros((hp.shape[0], GLA_HEADS, GLA_DK, GLA_DV), jnp.float32)
        hp, sp, bufs_p = _layer(hp, mkv_p, s0, None, 0, *lw)
        hs, ss, bufs_s = _layer(hs, cache_mem_kv[l], state_gla[l],
                                (cache_swa_w128[l], cache_swa_w512[l], cache_swa_w2048[l]), PAST_LEN, *lw)
        gla_p.append(sp)
        gla_s.append(ss)
        mem_p.append(mkv_p)
        for gi in range(SWA_GROUPS):
            swa_p[gi].append(bufs_p[gi])
            swa_s[gi].append(bufs_s[gi])
    y_prompt = _rmsnorm(hp, g_final)
    y_sample = _rmsnorm(hs, g_final)
    gla_prompt = jnp.stack(gla_p)
    swa_w128_prompt = jnp.stack(swa_p[0])
    swa_w512_prompt = jnp.stack(swa_p[1])
    swa_w2048_prompt = jnp.stack(swa_p[2])
    mem_kv_prompt = jnp.stack(mem_p)
    gla_sample = jnp.stack(gla_s)
    swa_w128_sample = jnp.stack(swa_s[0])
    swa_w512_sample = jnp.stack(swa_s[1])
    swa_w2048_sample = jnp.stack(swa_s[2])
    return (y_prompt, y_sample, gla_prompt, swa_w128_prompt, swa_w512_prompt, swa_w2048_prompt, mem_kv_prompt,
            gla_sample, swa_w128_sample, swa_w512_sample, swa_w2048_sample)
```

```cpp
#include <hip/hip_runtime.h>
#include <cstdio>
#include <cstdint>
#define LAS __attribute__((address_space(3)))
#define GAS __attribute__((address_space(1)))
#define MK_N_LAUNCHES 1
namespace pg8 {
#define PG8_LAS __attribute__((address_space(3)))
typedef unsigned short bf16_t;
typedef short bf16x8 __attribute__((ext_vector_type(8)));
typedef float f32x4 __attribute__((ext_vector_type(4)));
typedef unsigned u32x4 __attribute__((ext_vector_type(4)));
constexpr int BM = 256, BK = 64, HALF = 128, HTB = HALF * BK * 2  , STAGE_BYTES = 8 * HTB, NXCD = 8, WGM = 8;

__host__ __device__ __forceinline__ int lds_byte(int r, int c) { const int st = (r >> 4) * 2 + (c >> 5), rr = r & 15, cc = c & 31, ob = rr * 64 + cc * 2; return st * 1024 + (ob ^ (((ob >> 9) & 1) << 5)); }
__host__ __device__ __forceinline__ void stage_rc(int b, int& R, int& C) { const int st = b / 1024, sb = b % 1024, swz = sb ^ (((sb >> 9) & 1) << 5); R = (st >> 1) * 16 + swz / 64; C = (st & 1) * 32 + (swz % 64) / 2; }
__host__ __device__ __forceinline__ int perm32(int rho) { const int n = rho >> 4, i = rho & 15; return 8 * (i >> 2) + 4 * n + (i & 3); }

struct Unit { int pm, pn; };
struct Gemm { const bf16_t* A; const bf16_t* Bt; int M, N, K; };

struct StaticOrder {
    int nM, nN, nwg, G, c;
    __host__ __device__ void init(int M, int N, int G_, int c_) { nM = M / BM; nN = N / BM; nwg = nM * nN; G = G_; c = c_; }
    __host__ __device__ bool next(int i, Unit& u) const {
        const long L = (long)i * G + c; if (L >= nwg) return false;
        int wgid = (int)L; { const int q = nwg / NXCD, r = nwg % NXCD, xcd = wgid % NXCD, off = wgid / NXCD; wgid = (xcd < r ? xcd * (q + 1) : r * (q + 1) + (xcd - r) * q) + off; }
        const int nig = WGM * nN, gid = wgid / nig, fm = gid * WGM, gsz = (nM - fm) < WGM ? (nM - fm) : WGM;
        u.pm = fm + ((wgid % nig) % gsz); u.pn = (wgid % nig) / gsz; return true;
    }
    __device__ __forceinline__ void a_ready(const Unit&) const {}
    __device__ __forceinline__ void done(const Unit&) const {}
};

__device__ __forceinline__ unsigned cvt_pk_bf16(float lo, float hi) { unsigned r; asm volatile("v_cvt_pk_bf16_f32 %0, %1, %2" : "=v"(r) : "v"(lo), "v"(hi)); return r; }

template <class Epi, class Sched, bool ALIGN_EPI = false, bool SP2 = false>
__device__ __forceinline__ void gemm_phase(PG8_LAS unsigned char* lds, const Gemm g, const Sched& S, const Epi& E) {
    const int tid = threadIdx.x, wid = __builtin_amdgcn_readfirstlane(tid >> 6), lane = tid & 63, wr = wid >> 2, wc = wid & 3, fr = lane & 15, fq = lane >> 4;
    const int K = g.K, nt = K / BK;
    unsigned voffA[2], voffB[2];
#pragma unroll
    for (int i = 0; i < 2; ++i) { int R, C; stage_rc(tid * 16 + i * 8192, R, C); const int Rb = Epi::PERM ? ((R & ~31) + perm32(R & 31)) : R;
        voffA[i] = (unsigned)(R * K + C) * 2u; voffB[i] = (unsigned)(Rb * K + C) * 2u; }
    const size_t kstep = (size_t)(BK * 2);
    const size_t hstep = (size_t)HALF * K * 2;
    const size_t tstep = 2 * hstep;
    const unsigned ldsw = (unsigned)wid * 1024u;
    const int aoff = lds_byte(wr * 64 + fr, fq * 8), boff = lds_byte(wc * 32 + fr, fq * 8);
#define PG8_SA(b, h) (((b) * 2 + (h)) * HTB)
#define PG8_SB(b, h) ((4 + (b) * 2 + (h)) * HTB)
#define PG8_STAGE(bufoff, gbase, voff) do { _Pragma("unroll") for (int _i = 0; _i < 2; ++_i) \
        __builtin_amdgcn_global_load_lds((const unsigned*)((const char*)(gbase) + (voff)[_i]), (PG8_LAS unsigned*)(lds + (bufoff) + ldsw + _i * 8192), 16, 0, 0); } while (0)
#define PG8_LDA(dst, b, h) do { _Pragma("unroll") for (int m = 0; m < 4; ++m) _Pragma("unroll") for (int k = 0; k < 2; ++k) dst[m][k] = *(const PG8_LAS bf16x8*)(lds + PG8_SA(b, h) + aoff + m * 2048 + k * 1024); } while (0)
#define PG8_LDB(dst, b, h) do { _Pragma("unroll") for (int n = 0; n < 2; ++n) _Pragma("unroll") for (int k = 0; k < 2; ++k) dst[n][k] = *(const PG8_LAS bf16x8*)(lds + PG8_SB(b, h) + boff + n * 2048 + k * 1024); } while (0)
#define PG8_MMA(ai, bj, At, Bt) do { __builtin_amdgcn_s_setprio(1); _Pragma("unroll") for (int m = 0; m < 4; ++m) _Pragma("unroll") for (int n = 0; n < 2; ++n) _Pragma("unroll") for (int k = 0; k < 2; ++k) \
        acc[ai][bj][m][n] = __builtin_amdgcn_mfma_f32_16x16x32_bf16(Bt[n][k], At[m][k], acc[ai][bj][m][n], 0, 0, 0); __builtin_amdgcn_s_setprio(0); } while (0)
#define PG8_WAIT_V(n) asm volatile("s_waitcnt vmcnt(" #n ")" ::: "memory")
#define PG8_WAIT_L(n) asm volatile("s_waitcnt lgkmcnt(" #n ")" ::: "memory")
#define PG8_BAR __builtin_amdgcn_s_barrier()
#define PG8_SCHED __builtin_amdgcn_sched_barrier(0)
    Unit cur, nxt; int ui = 0;
    if (!S.next(0, cur)) return;
    f32x4 acc[2][2][4][2];
#pragma unroll
    for (int a = 0; a < 2; ++a)
#pragma unroll
        for (int b = 0; b < 2; ++b)
#pragma unroll
            for (int m = 0; m < 4; ++m)
#pragma unroll
                for (int n = 0; n < 2; ++n) acc[a][b][m][n] = (f32x4){0.f, 0.f, 0.f, 0.f};
    bf16x8 At[4][2], B0[2][2], B1[2][2];
    const char* cA = (const char*)g.A + (size_t)cur.pm * tstep; const char* cB = (const char*)g.Bt + (size_t)cur.pn * tstep;
    S.a_ready(cur);
    if constexpr (SP2) {
        PG8_STAGE(PG8_SB(0, 0), cB, voffB); PG8_STAGE(PG8_SB(0, 1), cB + hstep, voffB); PG8_STAGE(PG8_SA(0, 0), cA, voffA); PG8_STAGE(PG8_SA(0, 1), cA + hstep, voffA);
        if (wr == 1) PG8_BAR;
        PG8_WAIT_V(2); PG8_BAR;
        PG8_STAGE(PG8_SB(1, 0), cB + kstep, voffB); PG8_STAGE(PG8_SA(1, 0), cA + kstep, voffA); PG8_STAGE(PG8_SB(1, 1), cB + hstep + kstep, voffB);
        PG8_WAIT_V(6); PG8_BAR;
    } else {
        PG8_STAGE(PG8_SB(0, 0), cB, voffB); PG8_STAGE(PG8_SA(0, 0), cA, voffA); PG8_STAGE(PG8_SB(0, 1), cB + hstep, voffB); PG8_STAGE(PG8_SA(0, 1), cA + hstep, voffA);
        if (wr == 1) PG8_BAR;
        PG8_WAIT_V(4); PG8_BAR;
        PG8_STAGE(PG8_SB(1, 0), cB + kstep, voffB); PG8_STAGE(PG8_SA(1, 0), cA + kstep, voffA); PG8_STAGE(PG8_SB(1, 1), cB + hstep + kstep, voffB);
        PG8_WAIT_V(6); PG8_BAR;
    }
    for (;;) {
        const bool has_next = S.next(ui + 1, nxt);
        const char* nA = has_next ? (const char*)g.A + (size_t)nxt.pm * tstep : cA; const char* nB = has_next ? (const char*)g.Bt + (size_t)nxt.pn * tstep : cB;
        for (int t = 0; t < nt; t += 2) {
            const bool last = (t == nt - 2);
            const char* a1 = cA + (size_t)(t + 1) * kstep;
            const char* a2 = last ? nA : cA + (size_t)(t + 2) * kstep; const char* b2 = last ? nB : cB + (size_t)(t + 2) * kstep;
            const char* a3 = a2 + kstep; const char* b3 = b2 + kstep;
            if (last && has_next) S.a_ready(nxt);
            if constexpr (Epi::HAS_MID) { if (t == Epi::T1 || t == Epi::T2) E.mid(acc, cur, t, wr, wc, fr, fq); }
            if constexpr (SP2) {
            PG8_LDB(B0, 0, 0); PG8_LDB(B1, 0, 1); PG8_SCHED; PG8_LDA(At, 0, 0); PG8_STAGE(PG8_SA(1, 1), a1 + hstep, voffA);
            PG8_WAIT_V(8); PG8_WAIT_L(0); PG8_BAR; PG8_MMA(0, 0, At, B0); PG8_MMA(0, 1, At, B1); PG8_BAR; PG8_SCHED;
            PG8_LDA(At, 0, 1); PG8_STAGE(PG8_SB(0, 0), b2, voffB); PG8_STAGE(PG8_SB(0, 1), b2 + hstep, voffB); PG8_STAGE(PG8_SA(0, 0), a2, voffA);
            PG8_WAIT_V(8); PG8_WAIT_L(0); PG8_BAR; PG8_MMA(1, 0, At, B0); PG8_MMA(1, 1, At, B1); PG8_BAR; PG8_SCHED;
            PG8_LDB(B0, 1, 0); PG8_LDB(B1, 1, 1); PG8_SCHED; PG8_LDA(At, 1, 0); PG8_STAGE(PG8_SA(0, 1), a2 + hstep, voffA);
            PG8_WAIT_V(8); PG8_WAIT_L(0); PG8_BAR; PG8_MMA(0, 0, At, B0); PG8_MMA(0, 1, At, B1); PG8_BAR; PG8_SCHED;
            PG8_LDA(At, 1, 1); PG8_STAGE(PG8_SB(1, 0), b3, voffB); PG8_STAGE(PG8_SB(1, 1), b3 + hstep, voffB); PG8_STAGE(PG8_SA(1, 0), a3, voffA);
            PG8_WAIT_V(8); PG8_WAIT_L(0); PG8_BAR; PG8_MMA(1, 0, At, B0); PG8_MMA(1, 1, At, B1); PG8_BAR; PG8_SCHED;
            } else {
            PG8_LDB(B0, 0, 0); PG8_SCHED; PG8_LDA(At, 0, 0); PG8_STAGE(PG8_SA(1, 1), a1 + hstep, voffA);
            PG8_WAIT_L(8); PG8_BAR; PG8_WAIT_L(0); PG8_MMA(0, 0, At, B0); PG8_BAR; PG8_SCHED;
            PG8_LDB(B1, 0, 1); PG8_STAGE(PG8_SB(0, 0), b2, voffB);
            PG8_BAR; PG8_WAIT_L(0); PG8_MMA(0, 1, At, B1); PG8_BAR;
            PG8_LDA(At, 0, 1); PG8_STAGE(PG8_SA(0, 0), a2, voffA);
            PG8_BAR; PG8_WAIT_L(0); PG8_MMA(1, 0, At, B0); PG8_BAR; PG8_SCHED;
            PG8_STAGE(PG8_SB(0, 1), b2 + hstep, voffB);
            PG8_WAIT_V(6); PG8_BAR; PG8_MMA(1, 1, At, B1); PG8_BAR;
            PG8_LDB(B0, 1, 0); PG8_SCHED; PG8_LDA(At, 1, 0); PG8_STAGE(PG8_SA(0, 1), a2 + hstep, voffA);
            PG8_WAIT_L(8); PG8_BAR; PG8_WAIT_L(0); PG8_MMA(0, 0, At, B0); PG8_BAR; PG8_SCHED;
            PG8_LDB(B1, 1, 1); PG8_STAGE(PG8_SB(1, 0), b3, voffB);
            PG8_BAR; PG8_WAIT_L(0); PG8_MMA(0, 1, At, B1); PG8_BAR;
            PG8_LDA(At, 1, 1); PG8_STAGE(PG8_SA(1, 0), a3, voffA);
            PG8_BAR; PG8_WAIT_L(0); PG8_MMA(1, 0, At, B0); PG8_BAR; PG8_SCHED;
            PG8_STAGE(PG8_SB(1, 1), b3 + hstep, voffB);
            PG8_WAIT_V(6); PG8_BAR; PG8_MMA(1, 1, At, B1); PG8_BAR;
            }
        }
        if constexpr (ALIGN_EPI) { if (wr == 0) PG8_BAR; }
        if constexpr (!Epi::AFTER_DRAIN) { E(acc, cur, wr, wc, fr, fq); S.done(cur); }
        if (!has_next) break;
#pragma unroll
        for (int a = 0; a < 2; ++a)
#pragma unroll
            for (int b = 0; b < 2; ++b)
#pragma unroll
                for (int m = 0; m < 4; ++m)
#pragma unroll
                    for (int n = 0; n < 2; ++n) acc[a][b][m][n] = (f32x4){0.f, 0.f, 0.f, 0.f};
        cur = nxt; cA = nA; cB = nB; ++ui;
        if constexpr (ALIGN_EPI) { if (wr == 1) PG8_BAR; }
    }
    PG8_WAIT_V(0);
    if constexpr (!ALIGN_EPI) { if (wr == 0) PG8_BAR; }
    PG8_BAR;
    if constexpr (Epi::AFTER_DRAIN) { E.fused(acc, cur, wr, wc, fr, fq, lds, wid, lane); S.done(cur); }
#undef PG8_SA
#undef PG8_SB
#undef PG8_STAGE
#undef PG8_LDA
#undef PG8_LDB
#undef PG8_MMA
#undef PG8_WAIT_V
#undef PG8_WAIT_L
#undef PG8_BAR
#undef PG8_SCHED
}
}
#define XB_TMO      128
#define XB_XCNT(j)  (256  + 64 * (j))
#define XB_XSUB(j)  (1280 + 64 * (j))
#define XB_XGEN(j)  (2304 + 64 * (j))
#define XB_TOP      3328
#define XB_TOPGEN   3392
#define XCD_BAR_WORDS 3456
#define XB_SPIN_CAP (1u << 18)

__device__ __forceinline__ unsigned xb_ld(unsigned* p)              { return __hip_atomic_load(p, __ATOMIC_RELAXED, __HIP_MEMORY_SCOPE_AGENT); }
__device__ __forceinline__ unsigned xb_add(unsigned* p, unsigned v) { return __hip_atomic_fetch_add(p, v, __ATOMIC_RELAXED, __HIP_MEMORY_SCOPE_AGENT); }
__device__ __forceinline__ unsigned xb_xcc_id() { return (unsigned)__builtin_amdgcn_s_getreg((3 << 11) | 20) & 0xFu; }
#define XB_SPIN(cond, bar) do { unsigned _sp = 0; while (cond) { __builtin_amdgcn_s_sleep(1); \
    if ((++_sp & 255u) == 0u) { if (xb_ld(&(bar)[XB_TMO])) break; if (_sp > XB_SPIN_CAP) { atomicAdd(&(bar)[XB_TMO], 1u); break; } } } } while (0)

struct XcdBarrier {
    unsigned* bar; unsigned x;
    volatile LAS unsigned* st;
};

__device__ __forceinline__ XcdBarrier xcd_barrier_post(unsigned* bar, volatile LAS unsigned* st) {
    XcdBarrier b; b.bar = bar; b.x = xb_xcc_id(); b.st = st;
    if (threadIdx.x == 0) (void)xb_add(&bar[XB_XCNT(b.x)], 1u);
    return b;
}
__device__ __forceinline__ void xcd_barrier_complete(unsigned* bar, unsigned x, unsigned& nloc, unsigned& nx) {
    const unsigned G = gridDim.x * gridDim.y * gridDim.z;
    unsigned sum, cnt, mine, sp = 0u;
    for (;;) {
        sum = 0u; cnt = 0u; mine = 0u;
#pragma unroll
        for (unsigned j = 0; j < 16; ++j) { const unsigned c = xb_ld(&bar[XB_XCNT(j)]); sum += c; cnt += (c > 0u) ? 1u : 0u; mine = (j == x) ? c : mine; }
        if (sum == G) break;
        __builtin_amdgcn_s_sleep(1);
        if ((++sp & 255u) == 0u) { if (xb_ld(&bar[XB_TMO])) break; if (sp > XB_SPIN_CAP) { atomicAdd(&bar[XB_TMO], 1u); break; } }
    }
    nloc = mine > 0u ? mine : 1u; nx = cnt > 0u ? cnt : 1u;
}

__device__ __forceinline__ void xcd_barrier(const XcdBarrier& b) {
    asm volatile("s_waitcnt vmcnt(0)" ::: "memory");
    __syncthreads();
    if (threadIdx.x == 0) {
        unsigned* bar = b.bar;
        __builtin_amdgcn_s_waitcnt(0);
        unsigned nloc = b.st[0], nx = b.st[1];
        if (nloc == 0u) { xcd_barrier_complete(bar, b.x, nloc, nx); b.st[0] = nloc; b.st[1] = nx; }
        const unsigned old = xb_add(&bar[XB_XSUB(b.x)], 1u);
        const unsigned gen = old / nloc;
        if (old + 1u == (gen + 1u) * nloc) {
            __builtin_amdgcn_fence(__ATOMIC_RELEASE, "agent");
            asm volatile("s_waitcnt vmcnt(0)" ::: "memory");
            const unsigned og = xb_add(&bar[XB_TOP], 1u);
            const unsigned tg = og / nx;
            if (og + 1u == (tg + 1u) * nx) xb_add(&bar[XB_TOPGEN], 1u);
            else XB_SPIN(xb_ld(&bar[XB_TOPGEN]) == tg, bar);
            __builtin_amdgcn_fence(__ATOMIC_ACQUIRE, "agent");
            xb_add(&bar[XB_XGEN(b.x)], 1u);
            asm volatile("s_waitcnt vmcnt(0)" ::: "memory");
        } else {
            XB_SPIN(xb_ld(&bar[XB_XGEN(b.x)]) == gen, bar);
            __builtin_amdgcn_fence(__ATOMIC_ACQUIRE, "agent");
            asm volatile("s_waitcnt vmcnt(0)" ::: "memory");
        }
    }
    __syncthreads();
}

typedef unsigned short bf16_t;
typedef short bf16x8 __attribute__((ext_vector_type(8)));
typedef float f32x4 __attribute__((ext_vector_type(4)));
typedef float f32x2 __attribute__((ext_vector_type(2)));
typedef unsigned u32x4 __attribute__((ext_vector_type(4)));
typedef unsigned u32x2 __attribute__((ext_vector_type(2)));
typedef GAS unsigned gu32;

constexpr int NWAVES = 8, NTHR = 512;
constexpr int DM = 2048, SEQ = 8192, MP = 16384, MS = 32, MT = 16640;
constexpr int NIN = 15616, NIN_SRC = 15376;
constexpr float RMS_EPS = 1e-6f;
constexpr float QSCALE = 0.08838834764831845f;

constexpr size_t OFF_YP = 0, OFF_YS = 33554432, OFF_GLAP = OFF_YS + 65536, OFF_SWP0 = OFF_GLAP + 262144, OFF_SWP1 = OFF_SWP0 + 262144,
                 OFF_SWP2 = OFF_SWP1 + 1048576, OFF_MEMKV = OFF_SWP2 + 4194304, OFF_GLAS = OFF_MEMKV + 524288, OFF_SWS0 = OFF_GLAS + 4194304,
                 OFF_SWS1 = OFF_SWS0 + 4194304, OFF_SWS2 = OFF_SWS1 + 16777216, OUT_TOTAL = OFF_SWS2 + 67108864;
static_assert(OUT_TOTAL == 132186112, "output size");

constexpr size_t MiB = 1u << 20;
constexpr size_t WS_CTL = 0, CTL_ZERO_BYTES = 1 * MiB;
constexpr size_t WS_WTIN = 1 * MiB, WS_WTMID = 62 * MiB, WS_WTOUT = 70 * MiB, WS_WTMEM = 78 * MiB, WS_MEMH = 82 * MiB, WS_ROPEC = 84 * MiB, WS_ROPES = 87 * MiB,
                 WS_MKV = 90 * MiB, WS_GA = 91 * MiB, WS_ROWSS = 93 * MiB, WS_LSE = 96 * MiB, WS_GLAD = 97 * MiB, WS_H = 98 * MiB  , WS_GQ = 163 * MiB,
                 WS_GK = 180 * MiB, WS_GV = 197 * MiB, WS_GR = 230 * MiB, WS_SQ = 263 * MiB, WS_SK = 312 * MiB, WS_SV = 361 * MiB, WS_SR = 410 * MiB, WS_MQ = 427 * MiB,
                 WS_MR = 444 * MiB, WS_GT = 461 * MiB, WS_MERGED = 656 * MiB, WS_OB = 721 * MiB, WS_SLOC = 769 * MiB, WS_SSTART = 801 * MiB, WS_END = 833 * MiB;
constexpr int CW_BAR = 4096;

constexpr int LDS_BYTES = 163840;
constexpr int MISC_OFF = 163840 - 256;

struct Params { const float* in[20]; float* out; unsigned char* ws; int ph_lo, ph_hi; };

struct Ctx {
    LAS unsigned char* lds;
    int tid, lane, wave, vcu, G;
    const float* const* in; float* out; unsigned char* ws;
};

__device__ __forceinline__ float bf2f(unsigned short b) { return __uint_as_float(((unsigned)b) << 16); }
__device__ __forceinline__ unsigned short f2bf(float f) { unsigned u = __float_as_uint(f); return (unsigned short)((u + 0x7fffu + ((u >> 16) & 1u)) >> 16); }
__device__ __forceinline__ unsigned pk2(float lo, float hi) { return (unsigned)f2bf(lo) | ((unsigned)f2bf(hi) << 16); }
__device__ __forceinline__ float fsigmoid(float x) { return __fdividef(1.f, 1.f + __expf(-x)); }
__device__ __forceinline__ float fsilu(float x) { return __fdividef(x, 1.f + __expf(-x)); }
__device__ __forceinline__ float wave_sum(float v) {
#pragma unroll
    for (int o = 1; o < 64; o <<= 1) v += __shfl_xor(v, o);
    return v;
}
__device__ __forceinline__ float wave_max(float v) {
#pragma unroll
    for (int o = 1; o < 64; o <<= 1) v = fmaxf(v, __shfl_xor(v, o));
    return v;
}
__device__ __forceinline__ f32x4 mfma16(bf16x8 a, bf16x8 b, f32x4 c) { return __builtin_amdgcn_mfma_f32_16x16x32_bf16(a, b, c, 0, 0, 0); }
#define LDS_WAIT() asm volatile("s_waitcnt lgkmcnt(0)" ::: "memory")

__device__ __forceinline__ int win_srccol(int n) {
    if (n < 3072) return n;
    if (n < 6144) { const int seg = (n < 4608) ? 0 : 1; const int jj = n - (seg ? 4608 : 3072); const int head = jj >> 7, p = jj & 127; const int e = (p & 1) ? 64 + (p >> 1) : (p >> 1);
                    return (seg ? 4624 : 3088) + head * 128 + e; }
    if (n < 7680) return 6160 + (n - 6144);
    if (n < 8192) return 7696 + (n - 7680);
    if (n < 8704) return 8208 + (n - 8192);
    if (n < 9216) return 8720 + (n - 8704);
    if (n < 15360) return 9232 + (n - 9216);
    if (n < 15376) return 3072 + (n - 15360);
    return -1;
}
template <bool MAPPED>
__device__ __forceinline__ void p0_transpose_item(const float* W, int Nsrc, int nblk, bf16_t* WT, int ldk, int col_off, LAS float* scr, int item, int lane) {
    const int kb = item / nblk, nb = item % nblk, k0 = 64 * kb, n0 = 32 * nb;
    const int nn = n0 + (lane & 31); const int sc = MAPPED ? win_srccol(nn) : nn;
#pragma unroll 8
    for (int i = 0; i < 32; ++i) { const int kk = 2 * i + (lane >> 5); scr[kk * 33 + (lane & 31)] = (sc >= 0) ? W[(size_t)(k0 + kk) * Nsrc + sc] : 0.f; }
    LDS_WAIT(); asm volatile("" ::: "memory");
    const int c = lane & 7;
#pragma unroll
    for (int j = 0; j < 4; ++j) { const int n = (lane >> 3) + 8 * j; const LAS float* s = scr + (8 * c) * 33 + n;
        u32x4 o; o.x = pk2(s[0 * 33], s[1 * 33]); o.y = pk2(s[2 * 33], s[3 * 33]); o.z = pk2(s[4 * 33], s[5 * 33]); o.w = pk2(s[6 * 33], s[7 * 33]);
        *(u32x4*)(WT + (size_t)(n0 + n) * ldk + col_off + k0 + 8 * c) = o; }
    LDS_WAIT(); asm volatile("" ::: "memory");
}
__device__ __forceinline__ void rms_row_to_bf16(const float* xrow, const float* g, bf16_t* orow, int lane) {
    const f32x4* xr = (const f32x4*)xrow + lane; const f32x4* gr = (const f32x4*)g + lane;
    f32x4 v[8]; float s = 0.f;
#pragma unroll
    for (int j = 0; j < 8; ++j) { v[j] = xr[64 * j]; s += (v[j].x * v[j].x + v[j].y * v[j].y) + (v[j].z * v[j].z + v[j].w * v[j].w); }
    const float r = rsqrtf(wave_sum(s) * (1.f / DM) + RMS_EPS);
    u32x2* o8 = (u32x2*)orow + lane;
#pragma unroll
    for (int j = 0; j < 8; ++j) { const f32x4 gg = gr[64 * j]; u32x2 w; w.x = pk2(v[j].x * r * gg.x, v[j].y * r * gg.y); w.y = pk2(v[j].z * r * gg.z, v[j].w * r * gg.w); o8[64 * j] = w; }
}
__device__ __forceinline__ void p0_prep(const Ctx& C) {
    LAS float* scr = (LAS float*)(C.lds + C.wave * 16384);
    const int gw = C.vcu * NWAVES + C.wave, NGW = C.G * NWAVES, lane = C.lane;
    unsigned char* ws = C.ws;
    constexpr int I_IN = 32 * (NIN / 32), I_A = 16 * 64, I_B = 8 * 64, I_C = 8 * 64, I_O = 32 * 64, I_M = 32 * 32;
    constexpr int NITEMS = I_IN + I_A + I_B + I_C + I_O + I_M;
    for (int it = gw; it < NITEMS; it += NGW) {
        int r = it;
        if (r < I_IN) { p0_transpose_item<true>(C.in[9], NIN_SRC, NIN / 32, (bf16_t*)(ws + WS_WTIN), DM, 0, scr, r, lane); continue; } r -= I_IN;
        if (r < I_A) { p0_transpose_item<false>(C.in[15], DM, 64, (bf16_t*)(ws + WS_WTMID), DM, 0, scr, r, lane); continue; } r -= I_A;
        if (r < I_B) { p0_transpose_item<false>(C.in[16], DM, 64, (bf16_t*)(ws + WS_WTMID), DM, 1024, scr, r, lane); continue; } r -= I_B;
        if (r < I_C) { p0_transpose_item<false>(C.in[17], DM, 64, (bf16_t*)(ws + WS_WTMID), DM, 1536, scr, r, lane); continue; } r -= I_C;
        if (r < I_O) { p0_transpose_item<false>(C.in[18], DM, 64, (bf16_t*)(ws + WS_WTOUT), DM, 0, scr, r, lane); continue; } r -= I_O;
        p0_transpose_item<false>(C.in[14], 1024, 32, (bf16_t*)(ws + WS_WTMEM), DM, 0, scr, r, lane);
    }
    bf16_t* H = (bf16_t*)(ws + WS_H);
    for (int m = gw; m < MT + 512; m += NGW) {
        if (m < MP) rms_row_to_bf16(C.in[0] + (size_t)m * DM, C.in[8], H + (size_t)m * DM, lane);
        else if (m < MP + MS) rms_row_to_bf16(C.in[1] + (size_t)(m - MP) * DM, C.in[8], H + (size_t)m * DM, lane);
        else if (m < MT) { u32x4* o = (u32x4*)(H + (size_t)m * DM) + lane; const u32x4 z = {0u, 0u, 0u, 0u};
#pragma unroll
            for (int j = 0; j < 4; ++j) o[64 * j] = z; }
        else rms_row_to_bf16(C.in[2] + (size_t)(m - MT) * DM, C.in[13], (bf16_t*)(ws + WS_MEMH) + (size_t)(m - MT) * DM, lane);
    }
    float* rc = (float*)(ws + WS_ROPEC); float* rs = (float*)(ws + WS_ROPES);
    const int gt = C.vcu * NTHR + C.tid, NGT = C.G * NTHR;
    for (int i = gt; i < 8193 * 64; i += NGT) {
        const int p = i >> 6, f = i & 63; const double pos = (p == 8192) ? 16384.0 : (double)p;
        double inv = 1.0, b = 0.86596432336006535;
        for (int e = f; e; e >>= 1) { if (e & 1) inv *= b; b *= b; }
        const double rev = pos * inv * 0.15915494309189535;
        const float fr = (float)(rev - (double)(long long)rev);
        rc[i] = __builtin_amdgcn_cosf(fr); rs[i] = __builtin_amdgcn_sinf(fr);
    }
}

using pg8::Unit;
struct EpiIn {
    static constexpr bool PERM = true, AFTER_DRAIN = false, HAS_MID = false; static constexpr int T1 = -1, T2 = -1;
    unsigned char* ws; float* out;
    __device__ __forceinline__ void mid(f32x4 (&)[2][2][4][2], const Unit&, int, int, int, int, int) const {}
    __device__ __forceinline__ void operator()(const f32x4 (&acc)[2][2][4][2], const Unit& u, int wr, int wc, int fr, int fq) const {
        const int pn = u.pn, rbase = u.pm * 256 + wr * 64 + fr, cl = wc * 32 + 8 * fq;
        if (pn < 12 || (pn >= 30 && pn < 60)) {
            bf16_t* base; int pitch, ct, mode;
            if (pn < 2)       { base = (bf16_t*)(ws + WS_GQ); pitch = 512;  ct = pn * 256;        mode = 0; }
            else if (pn < 4)  { base = (bf16_t*)(ws + WS_GK); pitch = 512;  ct = (pn - 2) * 256;  mode = 0; }
            else if (pn < 8)  { base = (bf16_t*)(ws + WS_GV); pitch = 1024; ct = (pn - 4) * 256;  mode = 0; }
            else if (pn < 12) { base = (bf16_t*)(ws + WS_GR); pitch = 1024; ct = (pn - 8) * 256;  mode = 1; }
            else if (pn < 32) { base = (bf16_t*)(ws + WS_SR); pitch = 512;  ct = (pn - 30) * 256; mode = 1; }
            else if (pn < 34) { base = (bf16_t*)(ws + WS_MQ); pitch = 512;  ct = (pn - 32) * 256; mode = 3; }
            else if (pn < 36) { base = (bf16_t*)(ws + WS_MR); pitch = 512;  ct = (pn - 34) * 256; mode = 1; }
            else              { base = (bf16_t*)(ws + WS_GT); pitch = 6144; ct = (pn - 36) * 256; mode = 2; }
#pragma unroll
            for (int ai = 0; ai < 2; ++ai)
#pragma unroll
                for (int m = 0; m < 4; ++m) { bf16_t* rowp = base + (size_t)(rbase + ai * 128 + m * 16) * pitch + ct + cl;
#pragma unroll
                    for (int bj = 0; bj < 2; ++bj) { f32x4 v0 = acc[ai][bj][m][0], v1 = acc[ai][bj][m][1];
                        if (mode == 1) { v0 = (f32x4){fsilu(v0.x), fsilu(v0.y), fsilu(v0.z), fsilu(v0.w)}; v1 = (f32x4){fsilu(v1.x), fsilu(v1.y), fsilu(v1.z), fsilu(v1.w)}; }
                        else if (mode == 2) { v0 = (f32x4){fsigmoid(v0.x), fsigmoid(v0.y), fsigmoid(v0.z), fsigmoid(v0.w)}; v1 = (f32x4){fsigmoid(v1.x), fsigmoid(v1.y), fsigmoid(v1.z), fsigmoid(v1.w)}; }
                        else if (mode == 3) { v0 = v0 * QSCALE; v1 = v1 * QSCALE; }
                        u32x4 w; w.x = pk2(v0.x, v0.y); w.y = pk2(v0.z, v0.w); w.z = pk2(v1.x, v1.y); w.w = pk2(v1.z, v1.w);
                        *(u32x4*)(rowp + bj * 128) = w; } }
        } else if (pn < 24) {
            const bool isK = pn >= 18; const int t6 = isK ? pn - 18 : pn - 12; const int i0 = cl >> 1;
            bf16_t* base = (bf16_t*)(ws + (isK ? WS_SK : WS_SQ));
            const float* rc = (const float*)(ws + WS_ROPEC); const float* rs = (const float*)(ws + WS_ROPES);
#pragma unroll
            for (int ai = 0; ai < 2; ++ai)
#pragma unroll
                for (int m = 0; m < 4; ++m) { const int r = rbase + ai * 128 + m * 16; const int pidx = r < MP ? (r & 8191) : 8192;
                    const f32x4 c4 = *(const f32x4*)(rc + pidx * 64 + i0), s4 = *(const f32x4*)(rs + pidx * 64 + i0);
                    bf16_t* rowp = base + (size_t)r * 1536 + t6 * 256 + cl;
#pragma unroll
                    for (int bj = 0; bj < 2; ++bj) { const f32x4 v0 = acc[ai][bj][m][0], v1 = acc[ai][bj][m][1];
                        const f32x4 x1 = {v0.x, v0.z, v1.x, v1.z}, x2 = {v0.y, v0.w, v1.y, v1.w};
                        f32x4 y1 = x1 * c4 - x2 * s4, y2 = x2 * c4 + x1 * s4;
                        if (!isK) { y1 = y1 * QSCALE; y2 = y2 * QSCALE; }
                        u32x4 w; w.x = pk2(y1.x, y2.x); w.y = pk2(y1.y, y2.y); w.z = pk2(y1.z, y2.z); w.w = pk2(y1.w, y2.w);
                        *(u32x4*)(rowp + bj * 128) = w;
                        if (isK) { const int hg = 2 * t6 + bj, gi = hg >> 2, jh = hg & 3, W = 128 << (2 * gi);
                            float* dst = nullptr;
                            if (r < MP) { const int b = r >> 13, t = r & 8191; if (t >= SEQ - W) dst = out + (gi == 0 ? OFF_SWP0 : gi == 1 ? OFF_SWP1 : OFF_SWP2) + ((size_t)(b * W + (t - (SEQ - W))) * 2) * 512 + jh * 128; }
                            else if (r < MP + MS) dst = out + (gi == 0 ? OFF_SWS0 : gi == 1 ? OFF_SWS1 : OFF_SWS2) + ((size_t)((r - MP) * W + (W - 1)) * 2) * 512 + jh * 128;
                            if (dst) { *(f32x4*)(dst + i0) = y1; *(f32x4*)(dst + 64 + i0) = y2; } } } }
        } else if (pn < 30) {
            const int t6 = pn - 24; bf16_t* base = (bf16_t*)(ws + WS_SV);
#pragma unroll
            for (int ai = 0; ai < 2; ++ai)
#pragma unroll
                for (int m = 0; m < 4; ++m) { const int r = rbase + ai * 128 + m * 16; bf16_t* rowp = base + (size_t)r * 1536 + t6 * 256 + cl;
#pragma unroll
                    for (int bj = 0; bj < 2; ++bj) { const f32x4 v0 = acc[ai][bj][m][0], v1 = acc[ai][bj][m][1];
                        u32x4 w; w.x = pk2(v0.x, v0.y); w.y = pk2(v0.z, v0.w); w.z = pk2(v1.x, v1.y); w.w = pk2(v1.z, v1.w);
                        *(u32x4*)(rowp + bj * 128) = w;
                        const int hg = 2 * t6 + bj, gi = hg >> 2, jh = hg & 3, W = 128 << (2 * gi);
                        float* dst = nullptr;
                        if (r < MP) { const int b = r >> 13, t = r & 8191; if (t >= SEQ - W) dst = out + (gi == 0 ? OFF_SWP0 : gi == 1 ? OFF_SWP1 : OFF_SWP2) + ((size_t)(b * W + (t - (SEQ - W))) * 2 + 1) * 512 + jh * 128; }
                        else if (r < MP + MS) dst = out + (gi == 0 ? OFF_SWS0 : gi == 1 ? OFF_SWS1 : OFF_SWS2) + ((size_t)((r - MP) * W + (W - 1)) * 2 + 1) * 512 + jh * 128;
                        if (dst) { *(f32x4*)(dst + cl) = v0; *(f32x4*)(dst + cl + 4) = v1; } } }
        } else {
            if (wc == 0 && fq < 2) { float* ga = (float*)(ws + WS_GA);
#pragma unroll
                for (int ai = 0; ai < 2; ++ai)
#pragma unroll
                    for (int m = 0; m < 4; ++m) { float* p = ga + (size_t)(rbase + ai * 128 + m * 16) * 16 + 8 * fq; *(f32x4*)p = acc[ai][0][m][0]; *(f32x4*)(p + 4) = acc[ai][0][m][1]; } }
        }
    }
};
struct EpiMem {
    static constexpr bool PERM = false, AFTER_DRAIN = false, HAS_MID = false; static constexpr int T1 = -1, T2 = -1;
    float* o32; bf16_t* o16;
    __device__ __forceinline__ void mid(f32x4 (&)[2][2][4][2], const Unit&, int, int, int, int, int) const {}
    __device__ __forceinline__ void operator()(const f32x4 (&acc)[2][2][4][2], const Unit& u, int wr, int wc, int fr, int fq) const {
        const int row0 = u.pm * 256 + wr * 64 + fr, col0 = u.pn * 256 + wc * 32 + 4 * fq;
#pragma unroll
        for (int ai = 0; ai < 2; ++ai)
#pragma unroll
            for (int m = 0; m < 4; ++m) { const size_t ro = (size_t)(row0 + ai * 128 + m * 16) * 1024 + col0;
#pragma unroll
                for (int bj = 0; bj < 2; ++bj)
#pragma unroll
                    for (int n = 0; n < 2; ++n) { const f32x4 v = acc[ai][bj][m][n]; *(f32x4*)(o32 + ro + bj * 128 + n * 16) = v;
                        u32x2 w; w.x = pk2(v.x, v.y); w.y = pk2(v.z, v.w); *(u32x2*)(o16 + ro + bj * 128 + n * 16) = w; } }
    }
};
struct EpiMid {
    static constexpr bool PERM = true, AFTER_DRAIN = false, HAS_MID = true; static constexpr int T1 = 16, T2 = 24;
    const bf16_t* GT; bf16_t* merged;
    __device__ __forceinline__ void mid(f32x4 (&acc)[2][2][4][2], const Unit& u, int t, int wr, int wc, int fr, int fq) const {
        const int c0 = u.pn * 256 + wc * 32 + 8 * fq; const int gn = (t == T1) ? 0 : 2048;
        unsigned rb = (unsigned)(u.pm * 256 + wr * 64 + fr); asm volatile("" : "+v"(rb));
#pragma unroll
        for (int ai = 0; ai < 2; ++ai)
#pragma unroll
            for (int m = 0; m < 4; ++m) { const bf16_t* gp = GT + ((rb + (unsigned)(ai * 128 + m * 16)) * 6144u + (unsigned)(gn + c0));
#pragma unroll
                for (int bj = 0; bj < 2; ++bj) { const u32x4 a = *(const u32x4*)(gp + bj * 128), b = *(const u32x4*)(gp + 2048 + bj * 128);
                    f32x4 r0, r1;
                    r0.x = __fdividef(__uint_as_float(a.x << 16), fmaxf(__uint_as_float(b.x << 16), 1e-30f)); r0.y = __fdividef(__uint_as_float(a.x & 0xffff0000u), fmaxf(__uint_as_float(b.x & 0xffff0000u), 1e-30f));
                    r0.z = __fdividef(__uint_as_float(a.y << 16), fmaxf(__uint_as_float(b.y << 16), 1e-30f)); r0.w = __fdividef(__uint_as_float(a.y & 0xffff0000u), fmaxf(__uint_as_float(b.y & 0xffff0000u), 1e-30f));
                    r1.x = __fdividef(__uint_as_float(a.z << 16), fmaxf(__uint_as_float(b.z << 16), 1e-30f)); r1.y = __fdividef(__uint_as_float(a.z & 0xffff0000u), fmaxf(__uint_as_float(b.z & 0xffff0000u), 1e-30f));
                    r1.z = __fdividef(__uint_as_float(a.w << 16), fmaxf(__uint_as_float(b.w << 16), 1e-30f)); r1.w = __fdividef(__uint_as_float(a.w & 0xffff0000u), fmaxf(__uint_as_float(b.w & 0xffff0000u), 1e-30f));
                    acc[ai][bj][m][0] = acc[ai][bj][m][0] * r0; acc[ai][bj][m][1] = acc[ai][bj][m][1] * r1; }
                __builtin_amdgcn_sched_barrier(0); }
    }
    __device__ __forceinline__ void operator()(const f32x4 (&acc)[2][2][4][2], const Unit& u, int wr, int wc, int fr, int fq) const {
        const int rbase = u.pm * 256 + wr * 64 + fr, c0 = u.pn * 256 + wc * 32 + 8 * fq;
#pragma unroll
        for (int ai = 0; ai < 2; ++ai)
#pragma unroll
            for (int m = 0; m < 4; ++m) { const size_t r = (size_t)(rbase + ai * 128 + m * 16); const bf16_t* gp = GT + r * 6144 + 4096 + c0; bf16_t* op = merged + r * DM + c0;
#pragma unroll
                for (int bj = 0; bj < 2; ++bj) { const u32x4 g = *(const u32x4*)(gp + bj * 128); const f32x4 v0 = acc[ai][bj][m][0], v1 = acc[ai][bj][m][1];
                    u32x4 w; w.x = pk2(v0.x * __uint_as_float(g.x << 16), v0.y * __uint_as_float(g.x & 0xffff0000u)); w.y = pk2(v0.z * __uint_as_float(g.y << 16), v0.w * __uint_as_float(g.y & 0xffff0000u));
                    w.z = pk2(v1.x * __uint_as_float(g.z << 16), v1.y * __uint_as_float(g.z & 0xffff0000u)); w.w = pk2(v1.z * __uint_as_float(g.w << 16), v1.w * __uint_as_float(g.w & 0xffff0000u));
                    *(u32x4*)(op + bj * 128) = w; } }
    }
};
struct EpiOut {
    static constexpr bool PERM = false, AFTER_DRAIN = false, HAS_MID = false; static constexpr int T1 = -1, T2 = -1;
    const float* xp; const float* xs; float* out; float* rowss;
    __device__ __forceinline__ void mid(f32x4 (&)[2][2][4][2], const Unit&, int, int, int, int, int) const {}
    __device__ __forceinline__ void operator()(const f32x4 (&acc)[2][2][4][2], const Unit& u, int wr, int wc, int fr, int fq) const {
        const int row0 = u.pm * 256 + wr * 64 + fr, col0 = u.pn * 256 + wc * 32 + 4 * fq;
#pragma unroll
        for (int ai = 0; ai < 2; ++ai)
#pragma unroll
            for (int m = 0; m < 4; ++m) { const int r = row0 + ai * 128 + m * 16;
                const float* xr = (r < MP) ? xp + (size_t)r * DM : xs + (size_t)(r - MP) * DM; float* orow = (r < MP) ? out + OFF_YP + (size_t)r * DM : out + OFF_YS + (size_t)(r - MP) * DM;
                const bool ok = r < MP + MS; float ss = 0.f;
                if (ok) {
#pragma unroll
                    for (int bj = 0; bj < 2; ++bj)
#pragma unroll
                        for (int n = 0; n < 2; ++n) { const int c = col0 + bj * 128 + n * 16; const f32x4 v = acc[ai][bj][m][n] + *(const f32x4*)(xr + c); *(f32x4*)(orow + c) = v;
                            ss += (v.x * v.x + v.y * v.y) + (v.z * v.z + v.w * v.w); } }
                ss += __shfl_xor(ss, 16); ss += __shfl_xor(ss, 32);
                if (fq == 0) rowss[(size_t)r * 32 + u.pn * 4 + wc] = ss; }
    }
};
struct ShiftOrder : pg8::StaticOrder {
    __host__ __device__ void init2(int M, int N, int G_, int c_, int shift) { init(M, N, G_, (c_ - shift + G_) % G_); }
};

struct AttnArgs {
    const bf16_t* q; long qstride;
    const bf16_t* k; long kstride; const bf16_t* v; long vstride; int k_first;
    bf16_t* o; long ostride; float* lse; long lstride; const bf16_t* gate; long gstride;
};
constexpr int AT_KP = 272, AT_VP = 528, AT_VOFF = 256 * AT_KP;
template <int MODE>
__device__ __forceinline__ void attn_item(LAS unsigned char* lds, const AttnArgs& a, int tid_in) {
    constexpr int NP = (MODE == 0) ? 5 : 8;
    LAS unsigned char* Ks = lds; LAS unsigned char* Vt = lds + AT_VOFF;
    int tid = tid_in; asm volatile("" : "+v"(tid));
    const int lane = tid & 63, wid = tid >> 6, h = lane >> 4, l15 = lane & 15;
    {
        u32x4 kv[8], vv[8];
#pragma unroll
        for (int it = 0; it < 8; ++it) { const int c = tid + 512 * it, row = c >> 4, ch = c & 15; const u32x4 z = {0u, 0u, 0u, 0u};
            kv[it] = (row >= a.k_first) ? *(const u32x4*)(a.k + (unsigned)(row * (int)a.kstride + ch * 8)) : z;
            vv[it] = (row >= a.k_first) ? *(const u32x4*)(a.v + (unsigned)(row * (int)a.vstride + ch * 8)) : z; }
#pragma unroll
        for (int it = 0; it < 8; ++it) { const int c = tid + 512 * it, row = c >> 4, ch = c & 15;
            *(LAS u32x4*)(Ks + row * AT_KP + ch * 16) = kv[it];
            LAS unsigned short* vp = (LAS unsigned short*)(Vt + (ch * 8) * AT_VP + row * 2);
            vp[0 * (AT_VP / 2)] = (unsigned short)(vv[it].x & 0xffffu); vp[1 * (AT_VP / 2)] = (unsigned short)(vv[it].x >> 16);
            vp[2 * (AT_VP / 2)] = (unsigned short)(vv[it].y & 0xffffu); vp[3 * (AT_VP / 2)] = (unsigned short)(vv[it].y >> 16);
            vp[4 * (AT_VP / 2)] = (unsigned short)(vv[it].z & 0xffffu); vp[5 * (AT_VP / 2)] = (unsigned short)(vv[it].z >> 16);
            vp[6 * (AT_VP / 2)] = (unsigned short)(vv[it].w & 0xffffu); vp[7 * (AT_VP / 2)] = (unsigned short)(vv[it].w >> 16); }
    }
    const int jq = 16 * wid + l15;
    bf16x8 qf[4];
#pragma unroll
    for (int ks = 0; ks < 4; ++ks) qf[ks] = *(const bf16x8*)(a.q + (unsigned)(jq * (int)a.qstride + 8 * h + 32 * ks));
    __syncthreads();
    const int kb0 = (MODE == 0) ? (wid & ~1) : 0;
    f32x4 sc[2 * NP];
#pragma unroll
    for (int i = 0; i < 2 * NP; ++i) { f32x4 c = {0.f, 0.f, 0.f, 0.f};
#pragma unroll
        for (int ks = 0; ks < 4; ++ks) { const bf16x8 kf = *(const LAS bf16x8*)(Ks + (16 * (kb0 + i) + l15) * AT_KP + (8 * h + 32 * ks) * 2); c = mfma16(kf, qf[ks], c); }
        sc[i] = c; }
    float mx = -1e30f;
#pragma unroll
    for (int i = 0; i < 2 * NP; ++i)
#pragma unroll
        for (int r = 0; r < 4; ++r) { if (MODE == 0) { const int kk = 16 * (kb0 + i) + 4 * h + r; const bool ok = (kk >= jq) && (kk <= jq + 128) && (kk >= a.k_first); sc[i][r] = ok ? sc[i][r] : -1e30f; }
            mx = fmaxf(mx, sc[i][r]); }
    mx = fmaxf(mx, __shfl_xor(mx, 16)); mx = fmaxf(mx, __shfl_xor(mx, 32));
    float den = 0.f;
#pragma unroll
    for (int i = 0; i < 2 * NP; ++i)
#pragma unroll
        for (int r = 0; r < 4; ++r) { const float p = (sc[i][r] > -1e29f) ? __expf(sc[i][r] - mx) : 0.f; sc[i][r] = p; den += p; }
    den += __shfl_xor(den, 16); den += __shfl_xor(den, 32);
    f32x4 oa[8];
#pragma unroll
    for (int nb = 0; nb < 8; ++nb) oa[nb] = (f32x4){0.f, 0.f, 0.f, 0.f};
#pragma unroll
    for (int p = 0; p < NP; ++p) {
        bf16x8 pf; { const unsigned w0 = pk2(sc[2 * p][0], sc[2 * p][1]), w1 = pk2(sc[2 * p][2], sc[2 * p][3]), w2 = pk2(sc[2 * p + 1][0], sc[2 * p + 1][1]), w3 = pk2(sc[2 * p + 1][2], sc[2 * p + 1][3]);
            const u32x4 w = {w0, w1, w2, w3}; pf = __builtin_bit_cast(bf16x8, w); }
#pragma unroll
        for (int nb = 0; nb < 8; ++nb) { const LAS unsigned char* vp = Vt + (16 * nb + l15) * AT_VP + (16 * kb0 + 32 * p + 4 * h) * 2;
            const u32x2 lo = *(const LAS u32x2*)vp, hi = *(const LAS u32x2*)(vp + 32); const u32x4 w = {lo.x, lo.y, hi.x, hi.y};
            oa[nb] = mfma16(__builtin_bit_cast(bf16x8, w), pf, oa[nb]); }
    }
    const float rinv = __fdividef(1.f, den);
    bf16_t* op = a.o + (unsigned)(jq * (int)a.ostride + 4 * h);
#pragma unroll
    for (int nb = 0; nb < 8; ++nb) { f32x4 v = oa[nb] * rinv;
        if (MODE == 1) { const u32x2 g = *(const u32x2*)(a.gate + (unsigned)(jq * (int)a.gstride + 16 * nb + 4 * h));
            v.x *= __uint_as_float(g.x << 16); v.y *= __uint_as_float(g.x & 0xffff0000u); v.z *= __uint_as_float(g.y << 16); v.w *= __uint_as_float(g.y & 0xffff0000u); }
        u32x2 w; w.x = pk2(v.x, v.y); w.y = pk2(v.z, v.w); *(u32x2*)(op + 16 * nb) = w; }
    if (MODE == 0 && h == 0) a.lse[(unsigned)(jq * (int)a.lstride)] = mx + __logf(den);
    __syncthreads();
}

__device__ __forceinline__ void p2_attention(const Ctx& C) {
    unsigned char* ws = C.ws;
    for (int it = C.vcu; it < 2048; it += C.G) {
        AttnArgs a;
        if (it < 1536) {
            const int b = it / 768, rem = it % 768, hg = rem >> 6, rest = rem & 63, gi = hg >> 2, jh = hg & 3, dil = 1 << (2 * gi), nbr = 64 >> (2 * gi);
            const int r = rest / nbr, nb = rest % nbr;
            const long row0 = (long)b * SEQ + (long)nb * 128 * dil + r;
            a.q = (const bf16_t*)(ws + WS_SQ) + row0 * 1536 + hg * 128; a.qstride = (long)dil * 1536;
            const long krow0 = row0 - 128L * dil;
            a.k = (const bf16_t*)(ws + WS_SK) + krow0 * 1536 + hg * 128; a.kstride = (long)dil * 1536;
            a.v = (const bf16_t*)(ws + WS_SV) + krow0 * 1536 + hg * 128; a.vstride = (long)dil * 1536;
            a.k_first = (nb == 0) ? 128 : 0;
            a.o = (bf16_t*)(ws + WS_OB) + (size_t)gi * MP * 512 + row0 * 512 + jh * 128; a.ostride = (long)dil * 512;
            a.lse = (float*)(ws + WS_LSE) + (size_t)gi * MP * 4 + row0 * 4 + jh; a.lstride = (long)dil * 4;
            a.gate = nullptr; a.gstride = 0;
            attn_item<0>(C.lds, a, C.tid);
        } else {
            const int i2 = it - 1536, b = i2 >> 8, hh = (i2 >> 6) & 3, nb = i2 & 63;
            const long row0 = (long)b * SEQ + nb * 128;
            a.q = (const bf16_t*)(ws + WS_MQ) + row0 * 512 + hh * 128; a.qstride = 512;
            a.k = (const bf16_t*)(ws + WS_MKV) + (long)b * 256 * 1024 + hh * 128; a.kstride = 1024;
            a.v = (const bf16_t*)(ws + WS_MKV) + (long)b * 256 * 1024 + 512 + hh * 128; a.vstride = 1024; a.k_first = 0;
            a.o = (bf16_t*)(ws + WS_H) + row0 * DM + 1536 + hh * 128; a.ostride = DM; a.lse = nullptr; a.lstride = 0;
            a.gate = (const bf16_t*)(ws + WS_MR) + row0 * 512 + hh * 128; a.gstride = 512;
            attn_item<1>(C.lds, a, C.tid);
        }
    }
}

constexpr int GL_QT = 0, GL_KT = 17408, GL_KH = 34816, GL_VT = 53248, GL_AM = 90112, GL_GA = 99328, GL_TOT = 103424, GL_DV = 105472, GL_SSQ = 105984, GL_RINV = 108032, GL_KR = 108288, GL_QR = 125696;
constexpr int GL_P272 = 272, GL_P144 = 144;
template <bool FULL>
__device__ __forceinline__ void gla_item(const Ctx& C, int item) {
    LAS unsigned char* lds = C.lds; unsigned char* ws = C.ws;
    const int tid0 = C.tid;
    const int b = item >> 7, hh = (item >> 5) & 3, sc = item & 31;
    const long row0 = (long)b * SEQ + sc * 256;
    const bf16_t* GQ = (const bf16_t*)(ws + WS_GQ); const bf16_t* GK = (const bf16_t*)(ws + WS_GK); const bf16_t* GV = (const bf16_t*)(ws + WS_GV);
    const float* GA = (const float*)(ws + WS_GA);
    f32x4 S[8][2];
    if (FULL) { const float* sp = (const float*)(ws + WS_SSTART) + (size_t)item * 32768;
        unsigned sbase = (unsigned)((4 * ((tid0 & 63) >> 4)) * 256 + 32 * (tid0 >> 6) + (tid0 & 15)); asm volatile("" : "+v"(sbase));
#pragma unroll
        for (int kt = 0; kt < 8; ++kt)
#pragma unroll
            for (int vt = 0; vt < 2; ++vt)
#pragma unroll
                for (int r = 0; r < 4; ++r) S[kt][vt][r] = sp[sbase + (unsigned)((16 * kt + r) * 256 + 16 * vt)];
    } else {
#pragma unroll
        for (int kt = 0; kt < 8; ++kt)
#pragma unroll
            for (int vt = 0; vt < 2; ++vt) S[kt][vt] = (f32x4){0.f, 0.f, 0.f, 0.f};
    }
    float bsum = 0.f;
#pragma unroll 1
    for (int ch = 0; ch < 4; ++ch) {
        const long crow = row0 + ch * 64;
        int tid = tid0; asm volatile("" : "+v"(tid));
        const int lane = tid & 63, wid = tid >> 6, h4 = lane >> 4, l15 = lane & 15, kcol = tid & 127, tg = tid >> 7;
        float wa[16]; float bia;
        { unsigned kc = (unsigned)(hh * 128 + kcol); asm volatile("" : "+v"(kc));
#pragma unroll
          for (int r = 0; r < 16; ++r) wa[r] = C.in[10][r * 512 + kc];
          bia = C.in[11][kc]; }
        const unsigned crow32 = (unsigned)crow;
        if (tid < 256) ((LAS f32x4*)(lds + GL_GA))[tid] = ((const f32x4*)(GA + (size_t)crow32 * 16))[tid];
        {
            u32x4 vv[4], kk2[2], qq2[2];
#pragma unroll
            for (int it = 0; it < 4; ++it) { const unsigned c = tid + 512 * it, s = c >> 5, cc = c & 31; vv[it] = *(const u32x4*)(GV + ((crow32 + s) * 1024u + hh * 256 + cc * 8)); }
#pragma unroll
            for (int it = 0; it < 2; ++it) { const unsigned c = tid + 512 * it, s = c >> 4, cc = c & 15; kk2[it] = *(const u32x4*)(GK + ((crow32 + s) * 512u + hh * 128 + cc * 8));
                if (FULL) qq2[it] = *(const u32x4*)(GQ + ((crow32 + s) * 512u + hh * 128 + cc * 8)); }
#pragma unroll
            for (int it = 0; it < 2; ++it) { const unsigned c = tid + 512 * it, s = c >> 4, cc = c & 15; *(LAS u32x4*)(lds + GL_KR + s * GL_P272 + cc * 16) = kk2[it];
                if (FULL) *(LAS u32x4*)(lds + GL_QR + s * GL_P272 + cc * 16) = qq2[it]; }
#pragma unroll
            for (int it = 0; it < 4; ++it) { const int c = tid + 512 * it, s = c >> 5, cc = c & 31;
                LAS unsigned short* vp = (LAS unsigned short*)(lds + GL_VT + (cc * 8) * GL_P144 + s * 2);
                vp[0 * (GL_P144 / 2)] = (unsigned short)(vv[it].x & 0xffffu); vp[1 * (GL_P144 / 2)] = (unsigned short)(vv[it].x >> 16);
                vp[2 * (GL_P144 / 2)] = (unsigned short)(vv[it].y & 0xffffu); vp[3 * (GL_P144 / 2)] = (unsigned short)(vv[it].y >> 16);
                vp[4 * (GL_P144 / 2)] = (unsigned short)(vv[it].z & 0xffffu); vp[5 * (GL_P144 / 2)] = (unsigned short)(vv[it].z >> 16);
                vp[6 * (GL_P144 / 2)] = (unsigned short)(vv[it].w & 0xffffu); vp[7 * (GL_P144 / 2)] = (unsigned short)(vv[it].w >> 16); }
        }
        __syncthreads();
        float cs[16]; float run = 0.f;
#pragma unroll
        for (int i = 0; i < 16; ++i) { const LAS f32x4* gp = (const LAS f32x4*)(lds + GL_GA + (16 * tg + i) * 64); float x = bia;
#pragma unroll
            for (int q4 = 0; q4 < 4; ++q4) { const f32x4 g = gp[q4]; x += g.x * wa[4 * q4] + g.y * wa[4 * q4 + 1] + g.z * wa[4 * q4 + 2] + g.w * wa[4 * q4 + 3]; }
            const float ls = fminf(x, 0.f) - __logf(1.f + __expf(-fabsf(x)));
            run += ls * (1.f / 16.f); cs[i] = run; if ((i & 3) == 3) __builtin_amdgcn_sched_barrier(0); }
        ((LAS float*)(lds + GL_TOT))[tg * 128 + kcol] = run;
        __syncthreads();
        float off = 0.f, bend = 0.f;
#pragma unroll
        for (int g = 0; g < 4; ++g) { const float tt = ((LAS float*)(lds + GL_TOT))[g * 128 + kcol]; off += (g < tg) ? tt : 0.f; bend += tt; }
        if (tg == 0) ((LAS float*)(lds + GL_DV))[kcol] = __expf(bend);
        bsum += bend;
        { unsigned kh[8];
#pragma unroll
            for (int i = 0; i < 16; i += 2) { const float b0 = off + cs[i], b1 = off + cs[i + 1];
                const float k0 = bf2f(*(const LAS unsigned short*)(lds + GL_KR + (16 * tg + i) * GL_P272 + kcol * 2)), k1 = bf2f(*(const LAS unsigned short*)(lds + GL_KR + (16 * tg + i + 1) * GL_P272 + kcol * 2));
                kh[i >> 1] = pk2(k0 * __expf(bend - b0), k1 * __expf(bend - b1));
                if (FULL) { const float q0 = bf2f(*(const LAS unsigned short*)(lds + GL_QR + (16 * tg + i) * GL_P272 + kcol * 2)), q1 = bf2f(*(const LAS unsigned short*)(lds + GL_QR + (16 * tg + i + 1) * GL_P272 + kcol * 2));
                    *(LAS unsigned short*)(lds + GL_QT + (16 * tg + i) * GL_P272 + kcol * 2) = f2bf(q0 * __expf(b0) * QSCALE);
                    *(LAS unsigned short*)(lds + GL_QT + (16 * tg + i + 1) * GL_P272 + kcol * 2) = f2bf(q1 * __expf(b1) * QSCALE);
                    *(LAS unsigned short*)(lds + GL_KT + (16 * tg + i) * GL_P272 + kcol * 2) = f2bf(k0 * __expf(-b0));
                    *(LAS unsigned short*)(lds + GL_KT + (16 * tg + i + 1) * GL_P272 + kcol * 2) = f2bf(k1 * __expf(-b1)); } }
            LAS u32x4* kp = (LAS u32x4*)(lds + GL_KH + kcol * GL_P144 + tg * 32);
            kp[0] = (u32x4){kh[0], kh[1], kh[2], kh[3]}; kp[1] = (u32x4){kh[4], kh[5], kh[6], kh[7]}; }
        __syncthreads();
        f32x4 oacc[4][2];
        if (FULL) {
#pragma unroll
            for (int ti = 0; ti < 2; ++ti) { const int idx = 2 * wid + ti, tt = idx >> 2, st = idx & 3; f32x4 c = {0.f, 0.f, 0.f, 0.f};
                if (st <= tt) {
#pragma unroll
                    for (int ks = 0; ks < 4; ++ks) { const bf16x8 af = *(const LAS bf16x8*)(lds + GL_QT + (16 * tt + l15) * GL_P272 + (8 * h4 + 32 * ks) * 2);
                        const bf16x8 bfr = *(const LAS bf16x8*)(lds + GL_KT + (16 * st + l15) * GL_P272 + (8 * h4 + 32 * ks) * 2); c = mfma16(af, bfr, c); } }
#pragma unroll
                for (int r = 0; r < 4; ++r) { const int t = 16 * tt + 4 * h4 + r, s = 16 * st + l15;
                    *(LAS unsigned short*)(lds + GL_AM + t * GL_P144 + s * 2) = f2bf((t >= s) ? c[r] : 0.f); } }
#pragma unroll
            for (int tt = 0; tt < 4; ++tt)
#pragma unroll
                for (int vt = 0; vt < 2; ++vt) oacc[tt][vt] = (f32x4){0.f, 0.f, 0.f, 0.f};
#pragma unroll
            for (int ks = 0; ks < 4; ++ks) {
                bf16x8 sb[2];
#pragma unroll
                for (int vt = 0; vt < 2; ++vt) { const u32x4 w = {pk2(S[2 * ks][vt][0], S[2 * ks][vt][1]), pk2(S[2 * ks][vt][2], S[2 * ks][vt][3]), pk2(S[2 * ks + 1][vt][0], S[2 * ks + 1][vt][1]), pk2(S[2 * ks + 1][vt][2], S[2 * ks + 1][vt][3])};
                    sb[vt] = __builtin_bit_cast(bf16x8, w); }
#pragma unroll
                for (int tt = 0; tt < 4; ++tt) { const LAS unsigned char* qp = lds + GL_QT + (16 * tt + l15) * GL_P272 + (32 * ks + 4 * h4) * 2;
                    const u32x2 lo = *(const LAS u32x2*)qp, hi = *(const LAS u32x2*)(qp + 32); const u32x4 w = {lo.x, lo.y, hi.x, hi.y}; const bf16x8 qa = __builtin_bit_cast(bf16x8, w);
#pragma unroll
                    for (int vt = 0; vt < 2; ++vt) oacc[tt][vt] = mfma16(qa, sb[vt], oacc[tt][vt]); } }
            __syncthreads();
#pragma unroll
            for (int ks = 0; ks < 2; ++ks) {
                bf16x8 vb[2];
#pragma unroll
                for (int vt = 0; vt < 2; ++vt) vb[vt] = *(const LAS bf16x8*)(lds + GL_VT + (32 * wid + 16 * vt + l15) * GL_P144 + (32 * ks + 8 * h4) * 2);
#pragma unroll
                for (int tt = 0; tt < 4; ++tt) { const bf16x8 aa = *(const LAS bf16x8*)(lds + GL_AM + (16 * tt + l15) * GL_P144 + (32 * ks + 8 * h4) * 2);
#pragma unroll
                    for (int vt = 0; vt < 2; ++vt) oacc[tt][vt] = mfma16(aa, vb[vt], oacc[tt][vt]); } }
        }
#pragma unroll
        for (int kt = 0; kt < 8; ++kt) { const f32x4 d4 = *(const LAS f32x4*)(lds + GL_DV + (16 * kt + 4 * h4) * 4);
#pragma unroll
            for (int vt = 0; vt < 2; ++vt) S[kt][vt] = S[kt][vt] * d4; }
#pragma unroll
        for (int ks = 0; ks < 2; ++ks) {
            bf16x8 vb[2];
#pragma unroll
            for (int vt = 0; vt < 2; ++vt) vb[vt] = *(const LAS bf16x8*)(lds + GL_VT + (32 * wid + 16 * vt + l15) * GL_P144 + (32 * ks + 8 * h4) * 2);
#pragma unroll
            for (int kt = 0; kt < 8; ++kt) { const bf16x8 ka = *(const LAS bf16x8*)(lds + GL_KH + (16 * kt + l15) * GL_P144 + (32 * ks + 8 * h4) * 2);
#pragma unroll
                for (int vt = 0; vt < 2; ++vt) S[kt][vt] = mfma16(ka, vb[vt], S[kt][vt]); } }
        if (FULL) {
#pragma unroll
            for (int tt = 0; tt < 4; ++tt)
#pragma unroll
                for (int r = 0; r < 4; ++r) { float ss = oacc[tt][0][r] * oacc[tt][0][r] + oacc[tt][1][r] * oacc[tt][1][r];
                    ss += __shfl_xor(ss, 1); ss += __shfl_xor(ss, 2); ss += __shfl_xor(ss, 4); ss += __shfl_xor(ss, 8);
                    if (l15 == 0) ((LAS float*)(lds + GL_SSQ))[wid * 64 + 16 * tt + 4 * h4 + r] = ss; }
            __syncthreads();
            if (tid < 64) { float tot = 0.f;
#pragma unroll
                for (int w = 0; w < 8; ++w) tot += ((LAS float*)(lds + GL_SSQ))[w * 64 + tid];
                ((LAS float*)(lds + GL_RINV))[tid] = rsqrtf(tot * (1.f / 256.f) + RMS_EPS); }
            __syncthreads();
#pragma unroll
            for (int tt = 0; tt < 4; ++tt)
#pragma unroll
                for (int r = 0; r < 4; ++r) { const int t = 16 * tt + 4 * h4 + r; const float ri = ((LAS float*)(lds + GL_RINV))[t];
#pragma unroll
                    for (int vt = 0; vt < 2; ++vt) *(LAS unsigned short*)(lds + GL_QT + t * 528 + (32 * wid + 16 * vt + l15) * 2) = f2bf(oacc[tt][vt][r] * ri); }
            __syncthreads();
            {
                const bf16_t* GR = (const bf16_t*)(ws + WS_GR); bf16_t* U = (bf16_t*)(ws + WS_H);
#pragma unroll
                for (int it = 0; it < 4; ++it) { const unsigned c = tid + 512 * it, t = c >> 5, c8 = (c & 31) * 8; const unsigned col = hh * 256 + c8;
                    const u32x4 ov = *(const LAS u32x4*)(lds + GL_QT + t * 528 + c8 * 2); const u32x4 gr = *(const u32x4*)(GR + ((crow32 + t) * 1024u + col));
                    const f32x4 g0 = *(const f32x4*)(C.in[12] + col), g1 = *(const f32x4*)(C.in[12] + col + 4);
                    u32x4 w;
                    w.x = pk2(__uint_as_float(ov.x << 16) * g0.x * __uint_as_float(gr.x << 16), __uint_as_float(ov.x & 0xffff0000u) * g0.y * __uint_as_float(gr.x & 0xffff0000u));
                    w.y = pk2(__uint_as_float(ov.y << 16) * g0.z * __uint_as_float(gr.y << 16), __uint_as_float(ov.y & 0xffff0000u) * g0.w * __uint_as_float(gr.y & 0xffff0000u));
                    w.z = pk2(__uint_as_float(ov.z << 16) * g1.x * __uint_as_float(gr.z << 16), __uint_as_float(ov.z & 0xffff0000u) * g1.y * __uint_as_float(gr.z & 0xffff0000u));
                    w.w = pk2(__uint_as_float(ov.w << 16) * g1.z * __uint_as_float(gr.w << 16), __uint_as_float(ov.w & 0xffff0000u) * g1.w * __uint_as_float(gr.w & 0xffff0000u));
                    *(u32x4*)(U + ((size_t)(crow32 + t) * DM + col)) = w; }
            }
        }
        __syncthreads();
    }
    if (!FULL) {
        float* sl = (float*)(ws + WS_SLOC) + (size_t)item * 32768;
        unsigned sbase = (unsigned)((4 * ((tid0 & 63) >> 4)) * 256 + 32 * (tid0 >> 6) + (tid0 & 15)); asm volatile("" : "+v"(sbase));
#pragma unroll
        for (int kt = 0; kt < 8; ++kt)
#pragma unroll
            for (int vt = 0; vt < 2; ++vt)
#pragma unroll
                for (int r = 0; r < 4; ++r) sl[sbase + (unsigned)((16 * kt + r) * 256 + 16 * vt)] = S[kt][vt][r];
        if (tid0 < 128) ((float*)(ws + WS_GLAD))[item * 128 + tid0] = __expf(bsum);
    }
}
__device__ __forceinline__ void gla_scan(const Ctx& C) {
    unsigned char* ws = C.ws;
    const int g = C.vcu * NTHR + C.tid;
    if (g >= 131072) return;
    const int bh = g >> 14, rem = g & 16383, dk = rem >> 7, dv = (rem & 127) * 2;
    const float* sl = (const float*)(ws + WS_SLOC) + (size_t)bh * 32 * 32768 + dk * 256 + dv;
    float* ss = (float*)(ws + WS_SSTART) + (size_t)bh * 32 * 32768 + dk * 256 + dv;
    const float* dd = (const float*)(ws + WS_GLAD) + bh * 32 * 128 + dk;
    f32x2 loc[32]; float d[32];
#pragma unroll
    for (int s = 0; s < 32; ++s) { loc[s] = *(const f32x2*)(sl + (size_t)s * 32768); d[s] = dd[s * 128]; }
    f32x2 S = {0.f, 0.f};
#pragma unroll
    for (int s = 0; s < 32; ++s) { *(f32x2*)(ss + (size_t)s * 32768) = S; S = S * d[s] + loc[s]; }
    *(f32x2*)(C.out + OFF_GLAP + (size_t)bh * 32768 + dk * 256 + dv) = S;
}

__device__ __forceinline__ void dec_gla_item(const Ctx& C, int item) {
    LAS float* L = (LAS float*)C.lds;
    unsigned char* ws = C.ws; const int tid = C.tid, s = item >> 2, hh = item & 3; const long row = MP + s;
    if (tid < 128) { const float* ga = (const float*)(ws + WS_GA) + row * 16; float x = C.in[11][hh * 128 + tid];
#pragma unroll
        for (int r = 0; r < 16; ++r) x += ga[r] * C.in[10][r * 512 + hh * 128 + tid];
        const float ls = fminf(x, 0.f) - __logf(1.f + __expf(-fabsf(x)));
        L[tid] = __expf(ls * (1.f / 16.f));
        L[128 + tid] = bf2f(((const bf16_t*)(ws + WS_GQ))[row * 512 + hh * 128 + tid]) * QSCALE;
        L[256 + tid] = bf2f(((const bf16_t*)(ws + WS_GK))[row * 512 + hh * 128 + tid]); }
    __syncthreads();
    const int dv = tid & 255, half = tid >> 8;
    const float v = bf2f(((const bf16_t*)(ws + WS_GV))[row * 1024 + hh * 256 + dv]);
    const float* sp = C.in[3] + ((size_t)(s * 4 + hh) * 128 + half * 64) * 256 + dv; float* op = C.out + OFF_GLAS + ((size_t)(s * 4 + hh) * 128 + half * 64) * 256 + dv;
    float o = 0.f;
#pragma unroll 8
    for (int i = 0; i < 64; ++i) { const int dk = half * 64 + i; const float sn = L[dk] * sp[(size_t)i * 256] + L[256 + dk] * v; op[(size_t)i * 256] = sn; o += L[128 + dk] * sn; }
    L[384 + tid] = o;
    __syncthreads();
    float ot = 0.f, ss = 0.f;
    if (tid < 256) { ot = L[384 + tid] + L[384 + 256 + tid]; ss = ot * ot; }
    ss = wave_sum(ss);
    if (C.lane == 0) L[896 + C.wave] = ss;
    __syncthreads();
    if (tid < 256) { const float tot = L[896] + L[897] + L[898] + L[899]; const float ri = rsqrtf(tot * (1.f / 256.f) + RMS_EPS); const int col = hh * 256 + tid;
        ((bf16_t*)(ws + WS_H))[row * DM + col] = f2bf(ot * ri * C.in[12][col] * bf2f(((const bf16_t*)(ws + WS_GR))[row * 1024 + col])); }
    __syncthreads();
}
struct WaveAttn { float sc[7]; };
__device__ __forceinline__ float dot_reduce(float q1, float q2, float k1, float k2) { return wave_sum(q1 * k1 + q2 * k2); }
__device__ __forceinline__ void dec_swa_item(const Ctx& C, int item) {
    unsigned char* ws = C.ws; const int lane = C.lane, s = item >> 2, j = item & 3; const long row = MP + s;
    float sc[7];
#pragma unroll
    for (int i = 0; i < 7; ++i) sc[i] = -1e30f;
    float q1[3], q2[3], kn1[3], kn2[3], vn1[3], vn2[3];
#pragma unroll
    for (int g = 0; g < 3; ++g) {
        const int hg = g * 4 + j;
        const unsigned qq = *(const unsigned*)((const bf16_t*)(ws + WS_SQ) + row * 1536 + hg * 128 + 2 * lane);
        const unsigned kk = *(const unsigned*)((const bf16_t*)(ws + WS_SK) + row * 1536 + hg * 128 + 2 * lane);
        q1[g] = __uint_as_float(qq << 16); q2[g] = __uint_as_float(qq & 0xffff0000u); kn1[g] = __uint_as_float(kk << 16); kn2[g] = __uint_as_float(kk & 0xffff0000u);
        vn1[g] = bf2f(((const bf16_t*)(ws + WS_SV))[row * 1536 + hg * 128 + lane]); vn2[g] = bf2f(((const bf16_t*)(ws + WS_SV))[row * 1536 + hg * 128 + 64 + lane]);
    }
#pragma unroll
    for (int g = 0; g < 3; ++g) {
        const int W = 128 << (2 * g), dil = 1 << (2 * g);
        const float* cb = C.in[4 + g] + (size_t)s * W * 1024 + j * 128;
        { const float d = dot_reduce(q1[g], q2[g], kn1[g], kn2[g]); const int ki = g * 129;
#pragma unroll
          for (int sl = 0; sl < 7; ++sl) if ((ki >> 6) == sl && (ki & 63) == lane) sc[sl] = d; }
#pragma unroll 1
        for (int m0 = 1; m0 <= 128; m0 += 8) {
            float k1[8], k2[8];
#pragma unroll
            for (int u = 0; u < 8; ++u) { const float* kr = cb + (size_t)(W - dil * (m0 + u)) * 1024; k1[u] = kr[lane]; k2[u] = kr[64 + lane]; }
#pragma unroll
            for (int u = 0; u < 8; ++u) { const float d = dot_reduce(q1[g], q2[g], k1[u], k2[u]); const int ki = g * 129 + m0 + u;
#pragma unroll
                for (int sl = 0; sl < 7; ++sl) if ((ki >> 6) == sl && (ki & 63) == lane) sc[sl] = d; }
        }
    }
    float mx = -1e30f;
#pragma unroll
    for (int sl = 0; sl < 7; ++sl) mx = fmaxf(mx, sc[sl]);
    mx = wave_max(mx);
    float den = 0.f;
#pragma unroll
    for (int sl = 0; sl < 7; ++sl) { sc[sl] = (sc[sl] > -1e29f) ? __expf(sc[sl] - mx) : 0.f; den += sc[sl]; }
    den = wave_sum(den);
    float o1 = 0.f, o2 = 0.f;
#pragma unroll
    for (int g = 0; g < 3; ++g) {
        const int W = 128 << (2 * g), dil = 1 << (2 * g);
        const float* cb = C.in[4 + g] + (size_t)s * W * 1024 + 512 + j * 128;
        { const int ki = g * 129; float p = 0.f;
#pragma unroll
          for (int sl = 0; sl < 7; ++sl) if ((ki >> 6) == sl) p = __shfl(sc[sl], ki & 63);
          o1 += p * vn1[g]; o2 += p * vn2[g]; }
#pragma unroll 1
        for (int m0 = 1; m0 <= 128; m0 += 8) {
            float v1[8], v2[8];
#pragma unroll
            for (int u = 0; u < 8; ++u) { const float* vr = cb + (size_t)(W - dil * (m0 + u)) * 1024; v1[u] = vr[lane]; v2[u] = vr[64 + lane]; }
#pragma unroll
            for (int u = 0; u < 8; ++u) { const int ki = g * 129 + m0 + u; float p = 0.f;
#pragma unroll
                for (int sl = 0; sl < 7; ++sl) if ((ki >> 6) == sl) p = __shfl(sc[sl], ki & 63);
                o1 += p * v1[u]; o2 += p * v2[u]; }
        }
    }
    const float ri = __fdividef(1.f, den);
    const bf16_t* SR = (const bf16_t*)(ws + WS_SR) + row * 512 + j * 128; bf16_t* U = (bf16_t*)(ws + WS_H) + row * DM + 1024 + j * 128;
    U[lane] = f2bf(o1 * ri * bf2f(SR[lane])); U[64 + lane] = f2bf(o2 * ri * bf2f(SR[64 + lane]));
}
__device__ __forceinline__ void dec_mem_item(const Ctx& C, int item) {
    unsigned char* ws = C.ws; const int lane = C.lane, s = item >> 2, hh = item & 3; const long row = MP + s;
    const bf16_t* MQ = (const bf16_t*)(ws + WS_MQ) + row * 512 + hh * 128;
    const float q1 = bf2f(MQ[lane]), q2 = bf2f(MQ[64 + lane]);
    const float* cb = C.in[7] + (size_t)s * 256 * 1024 + hh * 128;
    float sc[4];
#pragma unroll
    for (int i = 0; i < 4; ++i) sc[i] = -1e30f;
#pragma unroll 1
    for (int m0 = 0; m0 < 256; m0 += 8) {
        float k1[8], k2[8];
#pragma unroll
        for (int u = 0; u < 8; ++u) { const float* kr = cb + (size_t)(m0 + u) * 1024; k1[u] = kr[lane]; k2[u] = kr[64 + lane]; }
#pragma unroll
        for (int u = 0; u < 8; ++u) { const float d = dot_reduce(q1, q2, k1[u], k2[u]); const int ki = m0 + u;
#pragma unroll
            for (int sl = 0; sl < 4; ++sl) if ((ki >> 6) == sl && (ki & 63) == lane) sc[sl] = d; }
    }
    float mx = fmaxf(fmaxf(sc[0], sc[1]), fmaxf(sc[2], sc[3])); mx = wave_max(mx);
    float den = 0.f;
#pragma unroll
    for (int sl = 0; sl < 4; ++sl) { sc[sl] = __expf(sc[sl] - mx); den += sc[sl]; }
    den = wave_sum(den);
    float o1 = 0.f, o2 = 0.f;
#pragma unroll 1
    for (int m0 = 0; m0 < 256; m0 += 8) {
        float v1[8], v2[8];
#pragma unroll
        for (int u = 0; u < 8; ++u) { const float* vr = cb + 512 + (size_t)(m0 + u) * 1024; v1[u] = vr[lane]; v2[u] = vr[64 + lane]; }
#pragma unroll
        for (int u = 0; u < 8; ++u) { const int ki = m0 + u; float p = 0.f;
#pragma unroll
            for (int sl = 0; sl < 4; ++sl) if ((ki >> 6) == sl) p = __shfl(sc[sl], ki & 63);
            o1 += p * v1[u]; o2 += p * v2[u]; }
    }
    const float ri = __fdividef(1.f, den);
    const bf16_t* MR = (const bf16_t*)(ws + WS_MR) + row * 512 + hh * 128; bf16_t* U = (bf16_t*)(ws + WS_H) + row * DM + 1536 + hh * 128;
    U[lane] = f2bf(o1 * ri * bf2f(MR[lane])); U[64 + lane] = f2bf(o2 * ri * bf2f(MR[64 + lane]));
}
__device__ __forceinline__ void p2_cache_copy(const Ctx& C) {
    const int sub = C.tid >> 8, t4 = C.tid & 255;
    constexpr int R0 = 32 * 127, R1 = 32 * 511, R2 = 32 * 2047, RT = R0 + R1 + R2;
    static_assert(RT % 8 == 0, "row groups");
    for (int rg = C.vcu * 2 + sub; rg < RT / 8; rg += C.G * 2) {
        f32x4 v[8]; f32x4* dp[8];
#pragma unroll
        for (int u = 0; u < 8; ++u) {
            int r = rg * 8 + u, g, W;
            if (r < R0) { g = 0; W = 128; } else if (r < R0 + R1) { r -= R0; g = 1; W = 512; } else { r -= R0 + R1; g = 2; W = 2048; }
            const int s = r / (W - 1), i = r % (W - 1);
            const f32x4* src = (const f32x4*)((g == 0 ? C.in[4] : g == 1 ? C.in[5] : C.in[6]) + ((size_t)s * W + i + 1) * 1024);
            dp[u] = (f32x4*)(C.out + (g == 0 ? OFF_SWS0 : g == 1 ? OFF_SWS1 : OFF_SWS2) + ((size_t)s * W + i) * 1024) + t4;
            v[u] = __builtin_nontemporal_load(src + t4);
        }
#pragma unroll
        for (int u = 0; u < 8; ++u) __builtin_nontemporal_store(v[u], dp[u]);
    }
}
__device__ __forceinline__ void p3_swa_combine(const Ctx& C) {
    unsigned char* ws = C.ws;
    const bf16_t* OB = (const bf16_t*)(ws + WS_OB); const float* LSE = (const float*)(ws + WS_LSE); const bf16_t* SR = (const bf16_t*)(ws + WS_SR); bf16_t* U = (bf16_t*)(ws + WS_H);
    for (int i = C.vcu * NTHR + C.tid; i < MP * 64; i += C.G * NTHR) {
        const int row = i >> 6, c8 = (i & 63) * 8, jh = c8 >> 7;
        const float l0 = LSE[(size_t)row * 4 + jh], l1 = LSE[(size_t)MP * 4 + (size_t)row * 4 + jh], l2 = LSE[(size_t)2 * MP * 4 + (size_t)row * 4 + jh];
        const float mx = fmaxf(l0, fmaxf(l1, l2)); float w0 = __expf(l0 - mx), w1 = __expf(l1 - mx), w2 = __expf(l2 - mx); const float ri = __fdividef(1.f, w0 + w1 + w2); w0 *= ri; w1 *= ri; w2 *= ri;
        const u32x4 a = *(const u32x4*)(OB + (size_t)row * 512 + c8), b = *(const u32x4*)(OB + (size_t)MP * 512 + (size_t)row * 512 + c8), c = *(const u32x4*)(OB + (size_t)2 * MP * 512 + (size_t)row * 512 + c8);
        const u32x4 g = *(const u32x4*)(SR + (size_t)row * 512 + c8);
        u32x4 o;
#define CMB(f) { const float lo = (w0 * __uint_as_float(a.f << 16) + w1 * __uint_as_float(b.f << 16) + w2 * __uint_as_float(c.f << 16)) * __uint_as_float(g.f << 16); \
                 const float hi = (w0 * __uint_as_float(a.f & 0xffff0000u) + w1 * __uint_as_float(b.f & 0xffff0000u) + w2 * __uint_as_float(c.f & 0xffff0000u)) * __uint_as_float(g.f & 0xffff0000u); o.f = pk2(lo, hi); }
        CMB(x) CMB(y) CMB(z) CMB(w)
#undef CMB
        *(u32x4*)(U + (size_t)row * DM + 1024 + c8) = o;
    }
}
__device__ __forceinline__ void p7_final_norm(const Ctx& C) {
    const float* rowss = (const float*)(C.ws + WS_ROWSS); const f32x4* gf = (const f32x4*)C.in[19] + C.lane;
    const int gw = C.vcu * NWAVES + C.wave, NGW = C.G * NWAVES;
    for (int r = gw; r < MP + MS; r += NGW) {
        float ss = (C.lane < 32) ? rowss[(size_t)r * 32 + C.lane] : 0.f; ss = wave_sum(ss);
        const float ri = rsqrtf(ss * (1.f / DM) + RMS_EPS);
        f32x4* y = (f32x4*)((r < MP) ? C.out + OFF_YP + (size_t)r * DM : C.out + OFF_YS + (size_t)(r - MP) * DM) + C.lane;
        f32x4 v[8];
#pragma unroll
        for (int j = 0; j < 8; ++j) v[j] = y[64 * j];
#pragma unroll
        for (int j = 0; j < 8; ++j) y[64 * j] = v[j] * ri * gf[64 * j];
    }
}

#ifndef MK_N_LAUNCHES
#define MK_N_LAUNCHES 1
#endif
constexpr int N_PHASES = 8;
__global__ void __launch_bounds__(NTHR, 2) fwd_kernel(Params P) {
    extern __shared__ __attribute__((aligned(16))) unsigned char lds_raw[];
    Ctx C;
    C.lds = (LAS unsigned char*)lds_raw;
    C.tid = threadIdx.x; C.lane = C.tid & 63; C.wave = __builtin_amdgcn_readfirstlane(C.tid >> 6);
    C.G = gridDim.x; { const int bx = blockIdx.x; C.vcu = (C.G % 8 == 0) ? (bx % 8) * (C.G / 8) + bx / 8 : bx; }
    C.in = P.in; C.out = P.out; C.ws = P.ws;
    volatile LAS unsigned* MISC = (volatile LAS unsigned*)(C.lds + MISC_OFF);
    if (C.tid < 64) MISC[C.tid] = 0u;
    __syncthreads();
    const int lo = P.ph_lo, hi = P.ph_hi;
    XcdBarrier bar; bar.bar = (unsigned*)(C.ws + WS_CTL) + CW_BAR; bar.x = 0; bar.st = nullptr;
    if (hi - lo > 1) bar = xcd_barrier_post((unsigned*)(C.ws + WS_CTL) + CW_BAR, MISC + 8);
#ifndef PH_MASK
#define PH_MASK 0xFF
#endif
#define IN(k) (((PH_MASK >> (k)) & 1) && lo <= (k) && (k) < hi)
#define SEAM(k) do { if (IN(k) && IN((k) + 1)) xcd_barrier(bar); FRESH(); } while (0)
#define FRESH() do { int t_ = threadIdx.x; asm volatile("" : "+v"(t_)); C.tid = t_; C.lane = t_ & 63; C.wave = __builtin_amdgcn_readfirstlane(t_ >> 6); } while (0)

    if (IN(0)) { p0_prep(C); }
    SEAM(0);
    if (IN(1)) {
        { pg8::Gemm g{(const bf16_t*)(C.ws + WS_H), (const bf16_t*)(C.ws + WS_WTIN), MT, NIN, DM}; pg8::StaticOrder S; S.init(MT, NIN, C.G, (int)blockIdx.x);
          EpiIn E{C.ws, C.out};
          pg8::gemm_phase<EpiIn, pg8::StaticOrder, true, true>(C.lds, g, S, E); }
        { pg8::Gemm g{(const bf16_t*)(C.ws + WS_MEMH), (const bf16_t*)(C.ws + WS_WTMEM), 512, 1024, DM}; ShiftOrder S; S.init2(512, 1024, C.G, (int)blockIdx.x, C.G / 2);
          EpiMem E{C.out + OFF_MEMKV, (bf16_t*)(C.ws + WS_MKV)};
          pg8::gemm_phase<EpiMem, ShiftOrder, true, true>(C.lds, g, S, E); }
    }
    SEAM(1);
    if (IN(2)) {
#ifndef P2_MASK
#define P2_MASK 0xFF
#endif
        if (P2_MASK & 1) for (int it = C.vcu; it < 256; it += C.G) gla_item<false>(C, it);
        if (P2_MASK & 2) p2_attention(C);
        if (P2_MASK & 4) for (int it = C.vcu; it < 128; it += C.G) dec_gla_item(C, it);
        { const int gw = ((C.vcu + C.G / 2) % C.G) * NWAVES + C.wave, NGW = C.G * NWAVES;
          for (int it = gw; it < 256; it += NGW) { if (it < 128) { if (P2_MASK & 8) dec_swa_item(C, it); } else { if (P2_MASK & 16) dec_mem_item(C, it - 128); } } }
        if (P2_MASK & 32) p2_cache_copy(C);
    }
    SEAM(2);
    if (IN(3)) { gla_scan(C); p3_swa_combine(C); }
    SEAM(3);
    if (IN(4)) { for (int it = C.vcu; it < 256; it += C.G) gla_item<true>(C, it); }
    SEAM(4);
    if (IN(5)) {
        pg8::Gemm g{(const bf16_t*)(C.ws + WS_H), (const bf16_t*)(C.ws + WS_WTMID), MT, DM, DM}; pg8::StaticOrder S; S.init(MT, DM, C.G, (int)blockIdx.x);
        EpiMid E{(const bf16_t*)(C.ws + WS_GT), (bf16_t*)(C.ws + WS_MERGED)};
        pg8::gemm_phase<EpiMid, pg8::StaticOrder, true, true>(C.lds, g, S, E);
    }
    SEAM(5);
    if (IN(6)) {
        pg8::Gemm g{(const bf16_t*)(C.ws + WS_MERGED), (const bf16_t*)(C.ws + WS_WTOUT), MT, DM, DM}; pg8::StaticOrder S; S.init(MT, DM, C.G, (int)blockIdx.x);
        EpiOut E{C.in[0], C.in[1], C.out, (float*)(C.ws + WS_ROWSS)};
        pg8::gemm_phase<EpiOut, pg8::StaticOrder, true, true>(C.lds, g, S, E);
    }
    SEAM(6);
    if (IN(7)) { p7_final_norm(C); }
#undef IN
#undef SEAM
}

extern "C" void kernel_launch(void* const* d_in, const int* in_sizes, int n_in, void* d_out, int out_size, void* d_ws, size_t ws_size, hipStream_t stream) {
    static int grid = 0;
    if (grid == 0) {
        if (n_in != 20 || in_sizes[0] != MP * DM || (size_t)out_size != OUT_TOTAL || ws_size < WS_END) {
            fprintf(stderr, "kernel_launch: unexpected shapes: n_in %d in0 %d out %d ws %zu (need %zu); nothing launched\n", n_in, n_in > 0 ? in_sizes[0] : -1, out_size, ws_size, (size_t)WS_END); grid = -1; return; }
        int dev = 0, cus = 0, per_cu = 0;
        if (hipGetDevice(&dev) != hipSuccess || hipDeviceGetAttribute(&cus, hipDeviceAttributeMultiprocessorCount, dev) != hipSuccess) { fprintf(stderr, "kernel_launch: device query failed\n"); grid = -1; return; }
        if (hipFuncSetAttribute((const void*)fwd_kernel, hipFuncAttributeMaxDynamicSharedMemorySize, LDS_BYTES) != hipSuccess) { fprintf(stderr, "kernel_launch: hipFuncSetAttribute failed\n"); grid = -1; return; }
        if (hipOccupancyMaxActiveBlocksPerMultiprocessor(&per_cu, (const void*)fwd_kernel, NTHR, LDS_BYTES) != hipSuccess || per_cu < 1) { fprintf(stderr, "kernel_launch: occupancy query says %d workgroups per CU\n", per_cu); per_cu = 1; }
        (void)hipGetLastError();
        grid = cus;
        fprintf(stderr, "kernel_launch: grid %d (occupancy query %d per CU)\n", grid, per_cu);
    }
    if (grid < 0) return;
    if (hipMemsetAsync((char*)d_ws + WS_CTL, 0, CTL_ZERO_BYTES, stream) != hipSuccess) { fprintf(stderr, "kernel_launch: memset failed\n"); return; }
    Params p{};
    for (int i = 0; i < 20; ++i) p.in[i] = (const float*)d_in[i];
    p.out = (float*)d_out; p.ws = (unsigned char*)d_ws;
#if MK_N_LAUNCHES == 1
    p.ph_lo = 0; p.ph_hi = N_PHASES;
    hipLaunchKernelGGL(fwd_kernel, dim3(grid), dim3(NTHR), LDS_BYTES, stream, p);
#else
    for (int k = 0; k < N_PHASES; ++k) { p.ph_lo = k; p.ph_hi = k + 1; hipLaunchKernelGGL(fwd_kernel, dim3(grid), dim3(NTHR), LDS_BYTES, stream, p); }
#endif
    const hipError_t le = hipPeekAtLastError();
    if (le != hipSuccess) fprintf(stderr, "kernel_launch: launch failed: %s\n", hipGetErrorName(le));
}
```

```cpp
#include <hip/hip_runtime.h>
#include <cstdio>
#include <cstdint>
#define LAS __attribute__((address_space(3)))
#define GAS __attribute__((address_space(1)))
#define MK_N_LAUNCHES 1
namespace pg8 {
#define PG8_LAS __attribute__((address_space(3)))
typedef unsigned short bf16_t;
typedef short bf16x8 __attribute__((ext_vector_type(8)));
typedef float f32x4 __attribute__((ext_vector_type(4)));
typedef unsigned u32x4 __attribute__((ext_vector_type(4)));
constexpr int BM = 256, BK = 64, HALF = 128, HTB = HALF * BK * 2  , STAGE_BYTES = 8 * HTB, NXCD = 8, WGM = 8;

__host__ __device__ __forceinline__ int lds_byte(int r, int c) { const int st = (r >> 4) * 2 + (c >> 5), rr = r & 15, cc = c & 31, ob = rr * 64 + cc * 2; return st * 1024 + (ob ^ (((ob >> 9) & 1) << 5)); }
__host__ __device__ __forceinline__ void stage_rc(int b, int& R, int& C) { const int st = b / 1024, sb = b % 1024, swz = sb ^ (((sb >> 9) & 1) << 5); R = (st >> 1) * 16 + swz / 64; C = (st & 1) * 32 + (swz % 64) / 2; }
__host__ __device__ __forceinline__ int perm32(int rho) { const int n = rho >> 4, i = rho & 15; return 8 * (i >> 2) + 4 * n + (i & 3); }

struct Unit { int pm, pn; };
struct Gemm { const bf16_t* A; const bf16_t* Bt; int M, N, K; };

struct StaticOrder {
    int nM, nN, nwg, G, c;
    __host__ __device__ void init(int M, int N, int G_, int c_) { nM = M / BM; nN = N / BM; nwg = nM * nN; G = G_; c = c_; }
    __host__ __device__ bool next(int i, Unit& u) const {
        const long L = (long)i * G + c; if (L >= nwg) return false;
        int wgid = (int)L; { const int q = nwg / NXCD, r = nwg % NXCD, xcd = wgid % NXCD, off = wgid / NXCD; wgid = (xcd < r ? xcd * (q + 1) : r * (q + 1) + (xcd - r) * q) + off; }
        const int nig = WGM * nN, gid = wgid / nig, fm = gid * WGM, gsz = (nM - fm) < WGM ? (nM - fm) : WGM;
        u.pm = fm + ((wgid % nig) % gsz); u.pn = (wgid % nig) / gsz; return true;
    }
    __device__ __forceinline__ void a_ready(const Unit&) const {}
    __device__ __forceinline__ void done(const Unit&) const {}
};

__device__ __forceinline__ unsigned cvt_pk_bf16(float lo, float hi) { unsigned r; asm volatile("v_cvt_pk_bf16_f32 %0, %1, %2" : "=v"(r) : "v"(lo), "v"(hi)); return r; }

template <class Epi, class Sched, bool ALIGN_EPI = false, bool SP2 = false>
__device__ __forceinline__ void gemm_phase(PG8_LAS unsigned char* lds, const Gemm g, const Sched& S, const Epi& E) {
    const int tid = threadIdx.x, wid = __builtin_amdgcn_readfirstlane(tid >> 6), lane = tid & 63, wr = wid >> 2, wc = wid & 3, fr = lane & 15, fq = lane >> 4;
    const int K = g.K, nt = K / BK;
    unsigned voffA[2], voffB[2];
#pragma unroll
    for (int i = 0; i < 2; ++i) { int R, C; stage_rc(tid * 16 + i * 8192, R, C); const int Rb = Epi::PERM ? ((R & ~31) + perm32(R & 31)) : R;
        voffA[i] = (unsigned)(R * K + C) * 2u; voffB[i] = (unsigned)(Rb * K + C) * 2u; }
    const size_t kstep = (size_t)(BK * 2);
    const size_t hstep = (size_t)HALF * K * 2;
    const size_t tstep = 2 * hstep;
    const unsigned ldsw = (unsigned)wid * 1024u;
    const int aoff = lds_byte(wr * 64 + fr, fq * 8), boff = lds_byte(wc * 32 + fr, fq * 8);
#define PG8_SA(b, h) (((b) * 2 + (h)) * HTB)
#define PG8_SB(b, h) ((4 + (b) * 2 + (h)) * HTB)
#define PG8_STAGE(bufoff, gbase, voff) do { _Pragma("unroll") for (int _i = 0; _i < 2; ++_i) \
        __builtin_amdgcn_global_load_lds((const unsigned*)((const char*)(gbase) + (voff)[_i]), (PG8_LAS unsigned*)(lds + (bufoff) + ldsw + _i * 8192), 16, 0, 0); } while (0)
#define PG8_LDA(dst, b, h) do { _Pragma("unroll") for (int m = 0; m < 4; ++m) _Pragma("unroll") for (int k = 0; k < 2; ++k) dst[m][k] = *(const PG8_LAS bf16x8*)(lds + PG8_SA(b, h) + aoff + m * 2048 + k * 1024); } while (0)
#define PG8_LDB(dst, b, h) do { _Pragma("unroll") for (int n = 0; n < 2; ++n) _Pragma("unroll") for (int k = 0; k < 2; ++k) dst[n][k] = *(const PG8_LAS bf16x8*)(lds + PG8_SB(b, h) + boff + n * 2048 + k * 1024); } while (0)
#define PG8_MMA(ai, bj, At, Bt) do { __builtin_amdgcn_s_setprio(1); _Pragma("unroll") for (int m = 0; m < 4; ++m) _Pragma("unroll") for (int n = 0; n < 2; ++n) _Pragma("unroll") for (int k = 0; k < 2; ++k) \
        acc[ai][bj][m][n] = __builtin_amdgcn_mfma_f32_16x16x32_bf16(Bt[n][k], At[m][k], acc[ai][bj][m][n], 0, 0, 0); __builtin_amdgcn_s_setprio(0); } while (0)
#define PG8_WAIT_V(n) asm volatile("s_waitcnt vmcnt(" #n ")" ::: "memory")
#define PG8_WAIT_L(n) asm volatile("s_waitcnt lgkmcnt(" #n ")" ::: "memory")
#define PG8_BAR __builtin_amdgcn_s_barrier()
#define PG8_SCHED __builtin_amdgcn_sched_barrier(0)
    Unit cur, nxt; int ui = 0;
    if (!S.next(0, cur)) return;
    f32x4 acc[2][2][4][2];
#pragma unroll
    for (int a = 0; a < 2; ++a)
#pragma unroll
        for (int b = 0; b < 2; ++b)
#pragma unroll
            for (int m = 0; m < 4; ++m)
#pragma unroll
                for (int n = 0; n < 2; ++n) acc[a][b][m][n] = (f32x4){0.f, 0.f, 0.f, 0.f};
    bf16x8 At[4][2], B0[2][2], B1[2][2];
    const char* cA = (const char*)g.A + (size_t)cur.pm * tstep; const char* cB = (const char*)g.Bt + (size_t)cur.pn * tstep;
    S.a_ready(cur);
    if constexpr (SP2) {
        PG8_STAGE(PG8_SB(0, 0), cB, voffB); PG8_STAGE(PG8_SB(0, 1), cB + hstep, voffB); PG8_STAGE(PG8_SA(0, 0), cA, voffA); PG8_STAGE(PG8_SA(0, 1), cA + hstep, voffA);
        if (wr == 1) PG8_BAR;
        PG8_WAIT_V(2); PG8_BAR;
        PG8_STAGE(PG8_SB(1, 0), cB + kstep, voffB); PG8_STAGE(PG8_SA(1, 0), cA + kstep, voffA); PG8_STAGE(PG8_SB(1, 1), cB + hstep + kstep, voffB);
        PG8_WAIT_V(6); PG8_BAR;
    } else {
        PG8_STAGE(PG8_SB(0, 0), cB, voffB); PG8_STAGE(PG8_SA(0, 0), cA, voffA); PG8_STAGE(PG8_SB(0, 1), cB + hstep, voffB); PG8_STAGE(PG8_SA(0, 1), cA + hstep, voffA);
        if (wr == 1) PG8_BAR;
        PG8_WAIT_V(4); PG8_BAR;
        PG8_STAGE(PG8_SB(1, 0), cB + kstep, voffB); PG8_STAGE(PG8_SA(1, 0), cA + kstep, voffA); PG8_STAGE(PG8_SB(1, 1), cB + hstep + kstep, voffB);
        PG8_WAIT_V(6); PG8_BAR;
    }
    for (;;) {
        const bool has_next = S.next(ui + 1, nxt);
        const char* nA = has_next ? (const char*)g.A + (size_t)nxt.pm * tstep : cA; const char* nB = has_next ? (const char*)g.Bt + (size_t)nxt.pn * tstep : cB;
        for (int t = 0; t < nt; t += 2) {
            const bool last = (t == nt - 2);
            const char* a1 = cA + (size_t)(t + 1) * kstep;
            const char* a2 = last ? nA : cA + (size_t)(t + 2) * kstep; const char* b2 = last ? nB : cB + (size_t)(t + 2) * kstep;
            const char* a3 = a2 + kstep; const char* b3 = b2 + kstep;
            if (last && has_next) S.a_ready(nxt);
            if constexpr (Epi::HAS_MID) { if (t == Epi::T1 || t == Epi::T2) E.mid(acc, cur, t, wr, wc, fr, fq); }
            if constexpr (SP2) {
            PG8_LDB(B0, 0, 0); PG8_LDB(B1, 0, 1); PG8_SCHED; PG8_LDA(At, 0, 0); PG8_STAGE(PG8_SA(1, 1), a1 + hstep, voffA);
            PG8_WAIT_V(8); PG8_WAIT_L(0); PG8_BAR; PG8_MMA(0, 0, At, B0); PG8_MMA(0, 1, At, B1); PG8_BAR; PG8_SCHED;
            PG8_LDA(At, 0, 1); PG8_STAGE(PG8_SB(0, 0), b2, voffB); PG8_STAGE(PG8_SB(0, 1), b2 + hstep, voffB); PG8_STAGE(PG8_SA(0, 0), a2, voffA);
            PG8_WAIT_V(8); PG8_WAIT_L(0); PG8_BAR; PG8_MMA(1, 0, At, B0); PG8_MMA(1, 1, At, B1); PG8_BAR; PG8_SCHED;
            PG8_LDB(B0, 1, 0); PG8_LDB(B1, 1, 1); PG8_SCHED; PG8_LDA(At, 1, 0); PG8_STAGE(PG8_SA(0, 1), a2 + hstep, voffA);
            PG8_WAIT_V(8); PG8_WAIT_L(0); PG8_BAR; PG8_MMA(0, 0, At, B0); PG8_MMA(0, 1, At, B1); PG8_BAR; PG8_SCHED;
            PG8_LDA(At, 1, 1); PG8_STAGE(PG8_SB(1, 0), b3, voffB); PG8_STAGE(PG8_SB(1, 1), b3 + hstep, voffB); PG8_STAGE(PG8_SA(1, 0), a3, voffA);
            PG8_WAIT_V(8); PG8_WAIT_L(0); PG8_BAR; PG8_MMA(1, 0, At, B0); PG8_MMA(1, 1, At, B1); PG8_BAR; PG8_SCHED;
            } else {
            PG8_LDB(B0, 0, 0); PG8_SCHED; PG8_LDA(At, 0, 0); PG8_STAGE(PG8_SA(1, 1), a1 + hstep, voffA);
            PG8_WAIT_L(8); PG8_BAR; PG8_WAIT_L(0); PG8_MMA(0, 0, At, B0); PG8_BAR; PG8_SCHED;
            PG8_LDB(B1, 0, 1); PG8_STAGE(PG8_SB(0, 0), b2, voffB);
            PG8_BAR; PG8_WAIT_L(0); PG8_MMA(0, 1, At, B1); PG8_BAR;
            PG8_LDA(At, 0, 1); PG8_STAGE(PG8_SA(0, 0), a2, voffA);
            PG8_BAR; PG8_WAIT_L(0); PG8_MMA(1, 0, At, B0); PG8_BAR; PG8_SCHED;
            PG8_STAGE(PG8_SB(0, 1), b2 + hstep, voffB);
            PG8_WAIT_V(6); PG8_BAR; PG8_MMA(1, 1, At, B1); PG8_BAR;
            PG8_LDB(B0, 1, 0); PG8_SCHED; PG8_LDA(At, 1, 0); PG8_STAGE(PG8_SA(0, 1), a2 + hstep, voffA);
            PG8_WAIT_L(8); PG8_BAR; PG8_WAIT_L(0); PG8_MMA(0, 0, At, B0); PG8_BAR; PG8_SCHED;
            PG8_LDB(B1, 1, 1); PG8_STAGE(PG8_SB(1, 0), b3, voffB);
            PG8_BAR; PG8_WAIT_L(0); PG8_MMA(0, 1, At, B1); PG8_BAR;
            PG8_LDA(At, 1, 1); PG8_STAGE(PG8_SA(1, 0), a3, voffA);
            PG8_BAR; PG8_WAIT_L(0); PG8_MMA(1, 0, At, B0); PG8_BAR; PG8_SCHED;
            PG8_STAGE(PG8_SB(1, 1), b3 + hstep, voffB);
            PG8_WAIT_V(6); PG8_BAR; PG8_MMA(1, 1, At, B1); PG8_BAR;
            }
        }
        if constexpr (ALIGN_EPI) { if (wr == 0) PG8_BAR; }
        if constexpr (!Epi::AFTER_DRAIN) { E(acc, cur, wr, wc, fr, fq); S.done(cur); }
        if (!has_next) break;
#pragma unroll
        for (int a = 0; a < 2; ++a)
#pragma unroll
            for (int b = 0; b < 2; ++b)
#pragma unroll
                for (int m = 0; m < 4; ++m)
#pragma unroll
                    for (int n = 0; n < 2; ++n) acc[a][b][m][n] = (f32x4){0.f, 0.f, 0.f, 0.f};
        cur = nxt; cA = nA; cB = nB; ++ui;
        if constexpr (ALIGN_EPI) { if (wr == 1) PG8_BAR; }
    }
    PG8_WAIT_V(0);
    if constexpr (!ALIGN_EPI) { if (wr == 0) PG8_BAR; }
    PG8_BAR;
    if constexpr (Epi::AFTER_DRAIN) { E.fused(acc, cur, wr, wc, fr, fq, lds, wid, lane); S.done(cur); }
#undef PG8_SA
#undef PG8_SB
#undef PG8_STAGE
#undef PG8_LDA
#undef PG8_LDB
#undef PG8_MMA
#undef PG8_WAIT_V
#undef PG8_WAIT_L
#undef PG8_BAR
#undef PG8_SCHED
}
}
#define XB_TMO      128
#define XB_XCNT(j)  (256  + 64 * (j))
#define XB_XSUB(j)  (1280 + 64 * (j))
#define XB_XGEN(j)  (2304 + 64 * (j))
#define XB_TOP      3328
#define XB_TOPGEN   3392
#define XCD_BAR_WORDS 3456
#define XB_SPIN_CAP (1u << 18)

__device__ __forceinline__ unsigned xb_ld(unsigned* p)              { return __hip_atomic_load(p, __ATOMIC_RELAXED, __HIP_MEMORY_SCOPE_AGENT); }
__device__ __forceinline__ unsigned xb_add(unsigned* p, unsigned v) { return __hip_atomic_fetch_add(p, v, __ATOMIC_RELAXED, __HIP_MEMORY_SCOPE_AGENT); }
__device__ __forceinline__ unsigned xb_xcc_id() { return (unsigned)__builtin_amdgcn_s_getreg((3 << 11) | 20) & 0xFu; }
#define XB_SPIN(cond, bar) do { unsigned _sp = 0; while (cond) { __builtin_amdgcn_s_sleep(1); \
    if ((++_sp & 255u) == 0u) { if (xb_ld(&(bar)[XB_TMO])) break; if (_sp > XB_SPIN_CAP) { atomicAdd(&(bar)[XB_TMO], 1u); break; } } } } while (0)

struct XcdBarrier {
    unsigned* bar; unsigned x;
    volatile LAS unsigned* st;
};

__device__ __forceinline__ XcdBarrier xcd_barrier_post(unsigned* bar, volatile LAS unsigned* st) {
    XcdBarrier b; b.bar = bar; b.x = xb_xcc_id(); b.st = st;
    if (threadIdx.x == 0) (void)xb_add(&bar[XB_XCNT(b.x)], 1u);
    return b;
}
__device__ __forceinline__ void xcd_barrier_complete(unsigned* bar, unsigned x, unsigned& nloc, unsigned& nx) {
    const unsigned G = gridDim.x * gridDim.y * gridDim.z;
    unsigned sum, cnt, mine, sp = 0u;
    for (;;) {
        sum = 0u; cnt = 0u; mine = 0u;
#pragma unroll
        for (unsigned j = 0; j < 16; ++j) { const unsigned c = xb_ld(&bar[XB_XCNT(j)]); sum += c; cnt += (c > 0u) ? 1u : 0u; mine = (j == x) ? c : mine; }
        if (sum == G) break;
        __builtin_amdgcn_s_sleep(1);
        if ((++sp & 255u) == 0u) { if (xb_ld(&bar[XB_TMO])) break; if (sp > XB_SPIN_CAP) { atomicAdd(&bar[XB_TMO], 1u); break; } }
    }
    nloc = mine > 0u ? mine : 1u; nx = cnt > 0u ? cnt : 1u;
}

__device__ __forceinline__ void xcd_barrier(const XcdBarrier& b) {
    asm volatile("s_waitcnt vmcnt(0)" ::: "memory");
    __syncthreads();
    if (threadIdx.x == 0) {
        unsigned* bar = b.bar;
        __builtin_amdgcn_s_waitcnt(0);
        unsigned nloc = b.st[0], nx = b.st[1];
        if (nloc == 0u) { xcd_barrier_complete(bar, b.x, nloc, nx); b.st[0] = nloc; b.st[1] = nx; }
        const unsigned old = xb_add(&bar[XB_XSUB(b.x)], 1u);
        const unsigned gen = old / nloc;
        if (old + 1u == (gen + 1u) * nloc) {
            __builtin_amdgcn_fence(__ATOMIC_RELEASE, "agent");
            asm volatile("s_waitcnt vmcnt(0)" ::: "memory");
            const unsigned og = xb_add(&bar[XB_TOP], 1u);
            const unsigned tg = og / nx;
            if (og + 1u == (tg + 1u) * nx) xb_add(&bar[XB_TOPGEN], 1u);
            else XB_SPIN(xb_ld(&bar[XB_TOPGEN]) == tg, bar);
            __builtin_amdgcn_fence(__ATOMIC_ACQUIRE, "agent");
            xb_add(&bar[XB_XGEN(b.x)], 1u);
            asm volatile("s_waitcnt vmcnt(0)" ::: "memory");
        } else {
            XB_SPIN(xb_ld(&bar[XB_XGEN(b.x)]) == gen, bar);
            __builtin_amdgcn_fence(__ATOMIC_ACQUIRE, "agent");
            asm volatile("s_waitcnt vmcnt(0)" ::: "memory");
        }
    }
    __syncthreads();
}

typedef unsigned short bf16_t;
typedef short bf16x8 __attribute__((ext_vector_type(8)));
typedef float f32x4 __attribute__((ext_vector_type(4)));
typedef float f32x2 __attribute__((ext_vector_type(2)));
typedef unsigned u32x4 __attribute__((ext_vector_type(4)));
typedef unsigned u32x2 __attribute__((ext_vector_type(2)));
typedef GAS unsigned gu32;

constexpr int NWAVES = 8, NTHR = 512;
constexpr int DM = 2048, SEQ = 8192, MP = 16384, MS = 32, MT = 16640;
constexpr int NIN = 15616, NIN_SRC = 15376;
constexpr float RMS_EPS = 1e-6f;
constexpr float QSCALE = 0.08838834764831845f;

constexpr size_t OFF_YP = 0, OFF_YS = 33554432, OFF_GLAP = OFF_YS + 65536, OFF_SWP0 = OFF_GLAP + 262144, OFF_SWP1 = OFF_SWP0 + 262144,
                 OFF_SWP2 = OFF_SWP1 + 1048576, OFF_MEMKV = OFF_SWP2 + 4194304, OFF_GLAS = OFF_MEMKV + 524288, OFF_SWS0 = OFF_GLAS + 4194304,
                 OFF_SWS1 = OFF_SWS0 + 4194304, OFF_SWS2 = OFF_SWS1 + 16777216, OUT_TOTAL = OFF_SWS2 + 67108864;
static_assert(OUT_TOTAL == 132186112, "output size");

constexpr size_t MiB = 1u << 20;
constexpr size_t WS_CTL = 0, CTL_ZERO_BYTES = 1 * MiB;
constexpr size_t WS_WTIN = 1 * MiB, WS_WTMID = 62 * MiB, WS_WTOUT = 70 * MiB, WS_WTMEM = 78 * MiB, WS_MEMH = 82 * MiB, WS_ROPEC = 84 * MiB, WS_ROPES = 87 * MiB,
                 WS_MKV = 90 * MiB, WS_GA = 91 * MiB, WS_ROWSS = 93 * MiB, WS_LSE = 96 * MiB, WS_GLAD = 97 * MiB, WS_H = 98 * MiB  , WS_GQ = 163 * MiB,
                 WS_GK = 180 * MiB, WS_GV = 197 * MiB, WS_GR = 230 * MiB, WS_SQ = 263 * MiB, WS_SK = 312 * MiB, WS_SV = 361 * MiB, WS_SR = 410 * MiB, WS_MQ = 427 * MiB,
                 WS_MR = 444 * MiB, WS_GT = 461 * MiB, WS_MERGED = 656 * MiB, WS_OB = 721 * MiB, WS_SLOC = 769 * MiB, WS_SSTART = 801 * MiB, WS_END = 833 * MiB;
constexpr int CW_BAR = 4096;

constexpr int LDS_BYTES = 163840;
constexpr int MISC_OFF = 163840 - 256;

struct Params { const float* in[20]; float* out; unsigned char* ws; int ph_lo, ph_hi; };

struct Ctx {
    LAS unsigned char* lds;
    int tid, lane, wave, vcu, G;
    const float* const* in; float* out; unsigned char* ws;
};

__device__ __forceinline__ float bf2f(unsigned short b) { return __uint_as_float(((unsigned)b) << 16); }
__device__ __forceinline__ unsigned short f2bf(float f) { unsigned u = __float_as_uint(f); return (unsigned short)((u + 0x7fffu + ((u >> 16) & 1u)) >> 16); }
__device__ __forceinline__ unsigned pk2(float lo, float hi) { return (unsigned)f2bf(lo) | ((unsigned)f2bf(hi) << 16); }
__device__ __forceinline__ float fsigmoid(float x) { return __fdividef(1.f, 1.f + __expf(-x)); }
__device__ __forceinline__ float fsilu(float x) { return __fdividef(x, 1.f + __expf(-x)); }
__device__ __forceinline__ float wave_sum(float v) {
#pragma unroll
    for (int o = 1; o < 64; o <<= 1) v += __shfl_xor(v, o);
    return v;
}
__device__ __forceinline__ float wave_max(float v) {
#pragma unroll
    for (int o = 1; o < 64; o <<= 1) v = fmaxf(v, __shfl_xor(v, o));
    return v;
}
__device__ __forceinline__ f32x4 mfma16(bf16x8 a, bf16x8 b, f32x4 c) { return __builtin_amdgcn_mfma_f32_16x16x32_bf16(a, b, c, 0, 0, 0); }
#define LDS_WAIT() asm volatile("s_waitcnt lgkmcnt(0)" ::: "memory")

__device__ __forceinline__ int win_srccol(int n) {
    if (n < 3072) return n;
    if (n < 6144) { const int seg = (n < 4608) ? 0 : 1; const int jj = n - (seg ? 4608 : 3072); const int head = jj >> 7, p = jj & 127; const int e = (p & 1) ? 64 + (p >> 1) : (p >> 1);
                    return (seg ? 4624 : 3088) + head * 128 + e; }
    if (n < 7680) return 6160 + (n - 6144);
    if (n < 8192) return 7696 + (n - 7680);
    if (n < 8704) return 8208 + (n - 8192);
    if (n < 9216) return 8720 + (n - 8704);
    if (n < 15360) return 9232 + (n - 9216);
    if (n < 15376) return 3072 + (n - 15360);
    return -1;
}
template <bool MAPPED>
__device__ __forceinline__ void p0_transpose_item(const float* W, int Nsrc, int nblk, bf16_t* WT, int ldk, int col_off, LAS float* scr, int item, int lane) {
    const int kb = item / nblk, nb = item % nblk, k0 = 64 * kb, n0 = 64 * nb;
    const int nn = n0 + lane; const int sc = MAPPED ? win_srccol(nn) : nn;
    const float* src = W + (size_t)k0 * Nsrc + (sc >= 0 ? sc : 0);
#pragma unroll
    for (int q = 0; q < 4; ++q) { float v[16];
#pragma unroll
        for (int i = 0; i < 16; ++i) v[i] = (sc >= 0) ? src[(size_t)(16 * q + i) * Nsrc] : 0.f;
#pragma unroll
        for (int i = 0; i < 16; ++i) scr[(16 * q + i) * 65 + lane] = v[i]; }
    LDS_WAIT(); asm volatile("" ::: "memory");
    const int c = lane & 7;
#pragma unroll
    for (int j = 0; j < 8; ++j) { const int n = (lane >> 3) + 8 * j; const LAS float* s = scr + (8 * c) * 65 + n;
        u32x4 o; o.x = pk2(s[0 * 65], s[1 * 65]); o.y = pk2(s[2 * 65], s[3 * 65]); o.z = pk2(s[4 * 65], s[5 * 65]); o.w = pk2(s[6 * 65], s[7 * 65]);
        *(u32x4*)(WT + (size_t)(n0 + n) * ldk + col_off + k0 + 8 * c) = o; }
    LDS_WAIT(); asm volatile("" ::: "memory");
}
__device__ __forceinline__ void rms_row_to_bf16(const float* xrow, const float* g, bf16_t* orow, int lane) {
    const f32x4* xr = (const f32x4*)xrow + lane; const f32x4* gr = (const f32x4*)g + lane;
    f32x4 v[8]; float s = 0.f;
#pragma unroll
    for (int j = 0; j < 8; ++j) { v[j] = xr[64 * j]; s += (v[j].x * v[j].x + v[j].y * v[j].y) + (v[j].z * v[j].z + v[j].w * v[j].w); }
    const float r = rsqrtf(wave_sum(s) * (1.f / DM) + RMS_EPS);
    u32x2* o8 = (u32x2*)orow + lane;
#pragma unroll
    for (int j = 0; j < 8; ++j) { const f32x4 gg = gr[64 * j]; u32x2 w; w.x = pk2(v[j].x * r * gg.x, v[j].y * r * gg.y); w.y = pk2(v[j].z * r * gg.z, v[j].w * r * gg.w); o8[64 * j] = w; }
}
__device__ __forceinline__ void p0_prep(const Ctx& C) {
    LAS float* scr = (LAS float*)(C.lds + C.wave * 16640);
    const int gw = C.vcu * NWAVES + C.wave, NGW = C.G * NWAVES, lane = C.lane;
    unsigned char* ws = C.ws;
    constexpr int I_IN = 32 * (NIN / 64), I_A = 16 * 32, I_B = 8 * 32, I_C = 8 * 32, I_O = 32 * 32, I_M = 32 * 16;
    constexpr int NITEMS = I_IN + I_A + I_B + I_C + I_O + I_M;
    for (int it = gw; it < NITEMS; it += NGW) {
        int r = it;
        if (r < I_IN) { p0_transpose_item<true>(C.in[9], NIN_SRC, NIN / 64, (bf16_t*)(ws + WS_WTIN), DM, 0, scr, r, lane); continue; } r -= I_IN;
        if (r < I_A) { p0_transpose_item<false>(C.in[15], DM, 32, (bf16_t*)(ws + WS_WTMID), DM, 0, scr, r, lane); continue; } r -= I_A;
        if (r < I_B) { p0_transpose_item<false>(C.in[16], DM, 32, (bf16_t*)(ws + WS_WTMID), DM, 1024, scr, r, lane); continue; } r -= I_B;
        if (r < I_C) { p0_transpose_item<false>(C.in[17], DM, 32, (bf16_t*)(ws + WS_WTMID), DM, 1536, scr, r, lane); continue; } r -= I_C;
        if (r < I_O) { p0_transpose_item<false>(C.in[18], DM, 32, (bf16_t*)(ws + WS_WTOUT), DM, 0, scr, r, lane); continue; } r -= I_O;
        p0_transpose_item<false>(C.in[14], 1024, 16, (bf16_t*)(ws + WS_WTMEM), DM, 0, scr, r, lane);
    }
    bf16_t* H = (bf16_t*)(ws + WS_H);
    for (int m = gw; m < MT + 512; m += NGW) {
        if (m < MP) rms_row_to_bf16(C.in[0] + (size_t)m * DM, C.in[8], H + (size_t)m * DM, lane);
        else if (m < MP + MS) rms_row_to_bf16(C.in[1] + (size_t)(m - MP) * DM, C.in[8], H + (size_t)m * DM, lane);
        else if (m < MT) { u32x4* o = (u32x4*)(H + (size_t)m * DM) + lane; const u32x4 z = {0u, 0u, 0u, 0u};
#pragma unroll
            for (int j = 0; j < 4; ++j) o[64 * j] = z; }
        else rms_row_to_bf16(C.in[2] + (size_t)(m - MT) * DM, C.in[13], (bf16_t*)(ws + WS_MEMH) + (size_t)(m - MT) * DM, lane);
    }
    float* rc = (float*)(ws + WS_ROPEC); float* rs = (float*)(ws + WS_ROPES);
    const int gt = C.vcu * NTHR + C.tid, NGT = C.G * NTHR;
    for (int i = gt; i < 8193 * 64; i += NGT) {
        const int p = i >> 6, f = i & 63; const double pos = (p == 8192) ? 16384.0 : (double)p;
        double inv = 1.0, b = 0.86596432336006535;
        for (int e = f; e; e >>= 1) { if (e & 1) inv *= b; b *= b; }
        const double rev = pos * inv * 0.15915494309189535;
        const float fr = (float)(rev - (double)(long long)rev);
        rc[i] = __builtin_amdgcn_cosf(fr); rs[i] = __builtin_amdgcn_sinf(fr);
    }
}

using pg8::Unit;
struct EpiIn {
    static constexpr bool PERM = true, AFTER_DRAIN = false, HAS_MID = false; static constexpr int T1 = -1, T2 = -1;
    unsigned char* ws; float* out;
    __device__ __forceinline__ void mid(f32x4 (&)[2][2][4][2], const Unit&, int, int, int, int, int) const {}
    __device__ __forceinline__ void operator()(const f32x4 (&acc)[2][2][4][2], const Unit& u, int wr, int wc, int fr, int fq) const {
        const int pn = u.pn, rbase = u.pm * 256 + wr * 64 + fr, cl = wc * 32 + 8 * fq;
        if (pn < 12 || (pn >= 30 && pn < 60)) {
            bf16_t* base; int pitch, ct, mode;
            if (pn < 2)       { base = (bf16_t*)(ws + WS_GQ); pitch = 512;  ct = pn * 256;        mode = 0; }
            else if (pn < 4)  { base = (bf16_t*)(ws + WS_GK); pitch = 512;  ct = (pn - 2) * 256;  mode = 0; }
            else if (pn < 8)  { base = (bf16_t*)(ws + WS_GV); pitch = 1024; ct = (pn - 4) * 256;  mode = 0; }
            else if (pn < 12) { base = (bf16_t*)(ws + WS_GR); pitch = 1024; ct = (pn - 8) * 256;  mode = 1; }
            else if (pn < 32) { base = (bf16_t*)(ws + WS_SR); pitch = 512;  ct = (pn - 30) * 256; mode = 1; }
            else if (pn < 34) { base = (bf16_t*)(ws + WS_MQ); pitch = 512;  ct = (pn - 32) * 256; mode = 3; }
            else if (pn < 36) { base = (bf16_t*)(ws + WS_MR); pitch = 512;  ct = (pn - 34) * 256; mode = 1; }
            else              { base = (bf16_t*)(ws + WS_GT); pitch = 6144; ct = (pn - 36) * 256; mode = 2; }
#pragma unroll
            for (int ai = 0; ai < 2; ++ai)
#pragma unroll
                for (int m = 0; m < 4; ++m) { bf16_t* rowp = base + (size_t)(rbase + ai * 128 + m * 16) * pitch + ct + cl;
#pragma unroll
                    for (int bj = 0; bj < 2; ++bj) { f32x4 v0 = acc[ai][bj][m][0], v1 = acc[ai][bj][m][1];
                        if (mode == 1) { v0 = (f32x4){fsilu(v0.x), fsilu(v0.y), fsilu(v0.z), fsilu(v0.w)}; v1 = (f32x4){fsilu(v1.x), fsilu(v1.y), fsilu(v1.z), fsilu(v1.w)}; }
                        else if (mode == 2) { v0 = (f32x4){fsigmoid(v0.x), fsigmoid(v0.y), fsigmoid(v0.z), fsigmoid(v0.w)}; v1 = (f32x4){fsigmoid(v1.x), fsigmoid(v1.y), fsigmoid(v1.z), fsigmoid(v1.w)}; }
                        else if (mode == 3) { v0 = v0 * QSCALE; v1 = v1 * QSCALE; }
                        u32x4 w; w.x = pk2(v0.x, v0.y); w.y = pk2(v0.z, v0.w); w.z = pk2(v1.x, v1.y); w.w = pk2(v1.z, v1.w);
                        *(u32x4*)(rowp + bj * 128) = w; } }
        } else if (pn < 24) {
            const bool isK = pn >= 18; const int t6 = isK ? pn - 18 : pn - 12; const int i0 = cl >> 1;
            bf16_t* base = (bf16_t*)(ws + (isK ? WS_SK : WS_SQ));
            const float* rc = (const float*)(ws + WS_ROPEC); const float* rs = (const float*)(ws + WS_ROPES);
#pragma unroll
            for (int ai = 0; ai < 2; ++ai)
#pragma unroll
                for (int m = 0; m < 4; ++m) { const int r = rbase + ai * 128 + m * 16; const int pidx = r < MP ? (r & 8191) : 8192;
                    const f32x4 c4 = *(const f32x4*)(rc + pidx * 64 + i0), s4 = *(const f32x4*)(rs + pidx * 64 + i0);
                    bf16_t* rowp = base + (size_t)r * 1536 + t6 * 256 + cl;
#pragma unroll
                    for (int bj = 0; bj < 2; ++bj) { const f32x4 v0 = acc[ai][bj][m][0], v1 = acc[ai][bj][m][1];
                        const f32x4 x1 = {v0.x, v0.z, v1.x, v1.z}, x2 = {v0.y, v0.w, v1.y, v1.w};
                        f32x4 y1 = x1 * c4 - x2 * s4, y2 = x2 * c4 + x1 * s4;
                        if (!isK) { y1 = y1 * QSCALE; y2 = y2 * QSCALE; }
                        u32x4 w; w.x = pk2(y1.x, y2.x); w.y = pk2(y1.y, y2.y); w.z = pk2(y1.z, y2.z); w.w = pk2(y1.w, y2.w);
                        *(u32x4*)(rowp + bj * 128) = w;
                        if (isK) { const int hg = 2 * t6 + bj, gi = hg >> 2, jh = hg & 3, W = 128 << (2 * gi);
                            float* dst = nullptr;
                            if (r < MP) { const int b = r >> 13, t = r & 8191; if (t >= SEQ - W) dst = out + (gi == 0 ? OFF_SWP0 : gi == 1 ? OFF_SWP1 : OFF_SWP2) + ((size_t)(b * W + (t - (SEQ - W))) * 2) * 512 + jh * 128; }
                            else if (r < MP + MS) dst = out + (gi == 0 ? OFF_SWS0 : gi == 1 ? OFF_SWS1 : OFF_SWS2) + ((size_t)((r - MP) * W + (W - 1)) * 2) * 512 + jh * 128;
                            if (dst) { *(f32x4*)(dst + i0) = y1; *(f32x4*)(dst + 64 + i0) = y2; } } } }
        } else if (pn < 30) {
            const int t6 = pn - 24; bf16_t* base = (bf16_t*)(ws + WS_SV);
#pragma unroll
            for (int ai = 0; ai < 2; ++ai)
#pragma unroll
                for (int m = 0; m < 4; ++m) { const int r = rbase + ai * 128 + m * 16; bf16_t* rowp = base + (size_t)r * 1536 + t6 * 256 + cl;
#pragma unroll
                    for (int bj = 0; bj < 2; ++bj) { const f32x4 v0 = acc[ai][bj][m][0], v1 = acc[ai][bj][m][1];
                        u32x4 w; w.x = pk2(v0.x, v0.y); w.y = pk2(v0.z, v0.w); w.z = pk2(v1.x, v1.y); w.w = pk2(v1.z, v1.w);
                        *(u32x4*)(rowp + bj * 128) = w;
                        const int hg = 2 * t6 + bj, gi = hg >> 2, jh = hg & 3, W = 128 << (2 * gi);
                        float* dst = nullptr;
                        if (r < MP) { const int b = r >> 13, t = r & 8191; if (t >= SEQ - W) dst = out + (gi == 0 ? OFF_SWP0 : gi == 1 ? OFF_SWP1 : OFF_SWP2) + ((size_t)(b * W + (t - (SEQ - W))) * 2 + 1) * 512 + jh * 128; }
                        else if (r < MP + MS) dst = out + (gi == 0 ? OFF_SWS0 : gi == 1 ? OFF_SWS1 : OFF_SWS2) + ((size_t)((r - MP) * W + (W - 1)) * 2 + 1) * 512 + jh * 128;
                        if (dst) { *(f32x4*)(dst + cl) = v0; *(f32x4*)(dst + cl + 4) = v1; } } }
        } else {
            if (wc == 0 && fq < 2) { float* ga = (float*)(ws + WS_GA);
#pragma unroll
                for (int ai = 0; ai < 2; ++ai)
#pragma unroll
                    for (int m = 0; m < 4; ++m) { float* p = ga + (size_t)(rbase + ai * 128 + m * 16) * 16 + 8 * fq; *(f32x4*)p = acc[ai][0][m][0]; *(f32x4*)(p + 4) = acc[ai][0][m][1]; } }
        }
    }
};
struct EpiMem {
    static constexpr bool PERM = false, AFTER_DRAIN = false, HAS_MID = false; static constexpr int T1 = -1, T2 = -1;
    float* o32; bf16_t* o16;
    __device__ __forceinline__ void mid(f32x4 (&)[2][2][4][2], const Unit&, int, int, int, int, int) const {}
    __device__ __forceinline__ void operator()(const f32x4 (&acc)[2][2][4][2], const Unit& u, int wr, int wc, int fr, int fq) const {
        const int row0 = u.pm * 256 + wr * 64 + fr, col0 = u.pn * 256 + wc * 32 + 4 * fq;
#pragma unroll
        for (int ai = 0; ai < 2; ++ai)
#pragma unroll
            for (int m = 0; m < 4; ++m) { const size_t ro = (size_t)(row0 + ai * 128 + m * 16) * 1024 + col0;
#pragma unroll
                for (int bj = 0; bj < 2; ++bj)
#pragma unroll
                    for (int n = 0; n < 2; ++n) { const f32x4 v = acc[ai][bj][m][n]; *(f32x4*)(o32 + ro + bj * 128 + n * 16) = v;
                        u32x2 w; w.x = pk2(v.x, v.y); w.y = pk2(v.z, v.w); *(u32x2*)(o16 + ro + bj * 128 + n * 16) = w; } }
    }
};
struct EpiMid {
    static constexpr bool PERM = true, AFTER_DRAIN = false, HAS_MID = true; static constexpr int T1 = 16, T2 = 24;
    const bf16_t* GT; bf16_t* merged;
    __device__ __forceinline__ void mid(f32x4 (&acc)[2][2][4][2], const Unit& u, int t, int wr, int wc, int fr, int fq) const {
        const int c0 = u.pn * 256 + wc * 32 + 8 * fq; const int gn = (t == T1) ? 0 : 2048;
        unsigned rb = (unsigned)(u.pm * 256 + wr * 64 + fr); asm volatile("" : "+v"(rb));
#pragma unroll
        for (int ai = 0; ai < 2; ++ai)
#pragma unroll
            for (int m = 0; m < 4; ++m) { const bf16_t* gp = GT + ((rb + (unsigned)(ai * 128 + m * 16)) * 6144u + (unsigned)(gn + c0));
#pragma unroll
                for (int bj = 0; bj < 2; ++bj) { const u32x4 a = *(const u32x4*)(gp + bj * 128), b = *(const u32x4*)(gp + 2048 + bj * 128);
                    f32x4 r0, r1;
                    r0.x = __fdividef(__uint_as_float(a.x << 16), fmaxf(__uint_as_float(b.x << 16), 1e-30f)); r0.y = __fdividef(__uint_as_float(a.x & 0xffff0000u), fmaxf(__uint_as_float(b.x & 0xffff0000u), 1e-30f));
                    r0.z = __fdividef(__uint_as_float(a.y << 16), fmaxf(__uint_as_float(b.y << 16), 1e-30f)); r0.w = __fdividef(__uint_as_float(a.y & 0xffff0000u), fmaxf(__uint_as_float(b.y & 0xffff0000u), 1e-30f));
                    r1.x = __fdividef(__uint_as_float(a.z << 16), fmaxf(__uint_as_float(b.z << 16), 1e-30f)); r1.y = __fdividef(__uint_as_float(a.z & 0xffff0000u), fmaxf(__uint_as_float(b.z & 0xffff0000u), 1e-30f));
                    r1.z = __fdividef(__uint_as_float(a.w << 16), fmaxf(__uint_as_float(b.w << 16), 1e-30f)); r1.w = __fdividef(__uint_as_float(a.w & 0xffff0000u), fmaxf(__uint_as_float(b.w & 0xffff0000u), 1e-30f));
                    acc[ai][bj][m][0] = acc[ai][bj][m][0] * r0; acc[ai][bj][m][1] = acc[ai][bj][m][1] * r1; }
                __builtin_amdgcn_sched_barrier(0); }
    }
    __device__ __forceinline__ void operator()(const f32x4 (&acc)[2][2][4][2], const Unit& u, int wr, int wc, int fr, int fq) const {
        const int rbase = u.pm * 256 + wr * 64 + fr, c0 = u.pn * 256 + wc * 32 + 8 * fq;
#pragma unroll
        for (int ai = 0; ai < 2; ++ai)
#pragma unroll
            for (int m = 0; m < 4; ++m) { const size_t r = (size_t)(rbase + ai * 128 + m * 16); const bf16_t* gp = GT + r * 6144 + 4096 + c0; bf16_t* op = merged + r * DM + c0;
#pragma unroll
                for (int bj = 0; bj < 2; ++bj) { const u32x4 g = *(const u32x4*)(gp + bj * 128); const f32x4 v0 = acc[ai][bj][m][0], v1 = acc[ai][bj][m][1];
                    u32x4 w; w.x = pk2(v0.x * __uint_as_float(g.x << 16), v0.y * __uint_as_float(g.x & 0xffff0000u)); w.y = pk2(v0.z * __uint_as_float(g.y << 16), v0.w * __uint_as_float(g.y & 0xffff0000u));
                    w.z = pk2(v1.x * __uint_as_float(g.z << 16), v1.y * __uint_as_float(g.z & 0xffff0000u)); w.w = pk2(v1.z * __uint_as_float(g.w << 16), v1.w * __uint_as_float(g.w & 0xffff0000u));
                    *(u32x4*)(op + bj * 128) = w; } }
    }
};
struct EpiOut {
    static constexpr bool PERM = false, AFTER_DRAIN = false, HAS_MID = false; static constexpr int T1 = -1, T2 = -1;
    const float* xp; const float* xs; float* out; float* rowss;
    __device__ __forceinline__ void mid(f32x4 (&)[2][2][4][2], const Unit&, int, int, int, int, int) const {}
    __device__ __forceinline__ void operator()(const f32x4 (&acc)[2][2][4][2], const Unit& u, int wr, int wc, int fr, int fq) const {
        const int row0 = u.pm * 256 + wr * 64 + fr, col0 = u.pn * 256 + wc * 32 + 4 * fq;
#pragma unroll
        for (int ai = 0; ai < 2; ++ai)
#pragma unroll
            for (int m = 0; m < 4; ++m) { const int r = row0 + ai * 128 + m * 16;
                const float* xr = (r < MP) ? xp + (size_t)r * DM : xs + (size_t)(r - MP) * DM; float* orow = (r < MP) ? out + OFF_YP + (size_t)r * DM : out + OFF_YS + (size_t)(r - MP) * DM;
                const bool ok = r < MP + MS; float ss = 0.f;
                if (ok) {
#pragma unroll
                    for (int bj = 0; bj < 2; ++bj)
#pragma unroll
                        for (int n = 0; n < 2; ++n) { const int c = col0 + bj * 128 + n * 16; const f32x4 v = acc[ai][bj][m][n] + *(const f32x4*)(xr + c); *(f32x4*)(orow + c) = v;
                            ss += (v.x * v.x + v.y * v.y) + (v.z * v.z + v.w * v.w); } }
                ss += __shfl_xor(ss, 16); ss += __shfl_xor(ss, 32);
                if (fq == 0) rowss[(size_t)r * 32 + u.pn * 4 + wc] = ss; }
    }
};
struct ShiftOrder : pg8::StaticOrder {
    __host__ __device__ void init2(int M, int N, int G_, int c_, int shift) { init(M, N, G_, (c_ - shift + G_) % G_); }
};

struct AttnArgs {
    const bf16_t* q; long qstride;
    const bf16_t* k; long kstride; const bf16_t* v; long vstride; int k_first;
    bf16_t* o; long ostride; float* lse; long lstride; const bf16_t* gate; long gstride;
};
constexpr int AT_KP = 272, AT_VP = 288, AT_VOFF = 256 * AT_KP;
typedef short v4i16 __attribute__((ext_vector_type(4)));
__device__ __forceinline__ bf16x8 tr_pair(const LAS unsigned char* p0, const LAS unsigned char* p1) {
    const v4i16 lo = __builtin_amdgcn_ds_read_tr16_b64_v4i16((LAS v4i16*)p0), hi = __builtin_amdgcn_ds_read_tr16_b64_v4i16((LAS v4i16*)p1);
    return (bf16x8){lo.x, lo.y, lo.z, lo.w, hi.x, hi.y, hi.z, hi.w};
}
template <int MODE>
__device__ __forceinline__ void attn_item(LAS unsigned char* lds, const AttnArgs& a, int tid_in) {
    constexpr int NP = (MODE == 0) ? 5 : 8;
    LAS unsigned char* Ks = lds; LAS unsigned char* Vt = lds + AT_VOFF;
    int tid = tid_in; asm volatile("" : "+v"(tid));
    const int lane = tid & 63, wid = tid >> 6, h = lane >> 4, l15 = lane & 15;
    {
        u32x4 kv[8], vv[8];
#pragma unroll
        for (int it = 0; it < 8; ++it) { const int c = tid + 512 * it, row = c >> 4, ch = c & 15; const u32x4 z = {0u, 0u, 0u, 0u};
            kv[it] = (row >= a.k_first) ? *(const u32x4*)(a.k + (unsigned)(row * (int)a.kstride + ch * 8)) : z;
            vv[it] = (row >= a.k_first) ? *(const u32x4*)(a.v + (unsigned)(row * (int)a.vstride + ch * 8)) : z; }
#pragma unroll
        for (int it = 0; it < 8; ++it) { const int c = tid + 512 * it, row = c >> 4, ch = c & 15;
            *(LAS u32x4*)(Ks + row * AT_KP + ch * 16) = kv[it];
            *(LAS u32x4*)(Vt + row * AT_VP + ch * 16) = vv[it]; }
    }
    const int jq = 16 * wid + l15;
    bf16x8 qf[4];
#pragma unroll
    for (int ks = 0; ks < 4; ++ks) qf[ks] = *(const bf16x8*)(a.q + (unsigned)(jq * (int)a.qstride + 8 * h + 32 * ks));
    __syncthreads();
    const int kb0 = (MODE == 0) ? (wid & ~1) : 0;
    f32x4 sc[2 * NP];
#pragma unroll
    for (int i = 0; i < 2 * NP; ++i) { f32x4 c = {0.f, 0.f, 0.f, 0.f};
#pragma unroll
        for (int ks = 0; ks < 4; ++ks) { const bf16x8 kf = *(const LAS bf16x8*)(Ks + (16 * (kb0 + i) + l15) * AT_KP + (8 * h + 32 * ks) * 2); c = mfma16(kf, qf[ks], c); }
        sc[i] = c; }
    float mx = -1e30f;
#pragma unroll
    for (int i = 0; i < 2 * NP; ++i)
#pragma unroll
        for (int r = 0; r < 4; ++r) { if (MODE == 0) { const int kk = 16 * (kb0 + i) + 4 * h + r; const bool ok = (kk >= jq) && (kk <= jq + 128) && (kk >= a.k_first); sc[i][r] = ok ? sc[i][r] : -1e30f; }
            mx = fmaxf(mx, sc[i][r]); }
    mx = fmaxf(mx, __shfl_xor(mx, 16)); mx = fmaxf(mx, __shfl_xor(mx, 32));
    float den = 0.f;
#pragma unroll
    for (int i = 0; i < 2 * NP; ++i)
#pragma unroll
        for (int r = 0; r < 4; ++r) { const float p = (sc[i][r] > -1e29f) ? __expf(sc[i][r] - mx) : 0.f; sc[i][r] = p; den += p; }
    den += __shfl_xor(den, 16); den += __shfl_xor(den, 32);
    f32x4 oa[8];
#pragma unroll
    for (int nb = 0; nb < 8; ++nb) oa[nb] = (f32x4){0.f, 0.f, 0.f, 0.f};
#pragma unroll
    for (int p = 0; p < NP; ++p) {
        bf16x8 pf; { const unsigned w0 = pk2(sc[2 * p][0], sc[2 * p][1]), w1 = pk2(sc[2 * p][2], sc[2 * p][3]), w2 = pk2(sc[2 * p + 1][0], sc[2 * p + 1][1]), w3 = pk2(sc[2 * p + 1][2], sc[2 * p + 1][3]);
            const u32x4 w = {w0, w1, w2, w3}; pf = __builtin_bit_cast(bf16x8, w); }
#pragma unroll
        for (int nb = 0; nb < 8; ++nb) { const LAS unsigned char* vp = Vt + (16 * kb0 + 32 * p + 4 * h + (l15 >> 2)) * AT_VP + (16 * nb + 4 * (l15 & 3)) * 2;
            oa[nb] = mfma16(tr_pair(vp, vp + 16 * AT_VP), pf, oa[nb]); }
    }
    const float rinv = __fdividef(1.f, den);
    bf16_t* op = a.o + (unsigned)(jq * (int)a.ostride + 4 * h);
#pragma unroll
    for (int nb = 0; nb < 8; ++nb) { f32x4 v = oa[nb] * rinv;
        if (MODE == 1) { const u32x2 g = *(const u32x2*)(a.gate + (unsigned)(jq * (int)a.gstride + 16 * nb + 4 * h));
            v.x *= __uint_as_float(g.x << 16); v.y *= __uint_as_float(g.x & 0xffff0000u); v.z *= __uint_as_float(g.y << 16); v.w *= __uint_as_float(g.y & 0xffff0000u); }
        u32x2 w; w.x = pk2(v.x, v.y); w.y = pk2(v.z, v.w); *(u32x2*)(op + 16 * nb) = w; }
    if (MODE == 0 && h == 0) a.lse[(unsigned)(jq * (int)a.lstride)] = mx + __logf(den);
    __syncthreads();
}

__device__ __forceinline__ void p2_attention(const Ctx& C) {
    unsigned char* ws = C.ws;
    for (int it = C.vcu; it < 2048; it += C.G) {
        AttnArgs a;
        if (it < 1536) {
            const int b = it / 768, rem = it % 768, hg = rem >> 6, rest = rem & 63, gi = hg >> 2, jh = hg & 3, dil = 1 << (2 * gi), nbr = 64 >> (2 * gi);
            const int r = rest / nbr, nb = rest % nbr;
            const long row0 = (long)b * SEQ + (long)nb * 128 * dil + r;
            a.q = (const bf16_t*)(ws + WS_SQ) + row0 * 1536 + hg * 128; a.qstride = (long)dil * 1536;
            const long krow0 = row0 - 128L * dil;
            a.k = (const bf16_t*)(ws + WS_SK) + krow0 * 1536 + hg * 128; a.kstride = (long)dil * 1536;
            a.v = (const bf16_t*)(ws + WS_SV) + krow0 * 1536 + hg * 128; a.vstride = (long)dil * 1536;
            a.k_first = (nb == 0) ? 128 : 0;
            a.o = (bf16_t*)(ws + WS_OB) + (size_t)gi * MP * 512 + row0 * 512 + jh * 128; a.ostride = (long)dil * 512;
            a.lse = (float*)(ws + WS_LSE) + (size_t)gi * MP * 4 + row0 * 4 + jh; a.lstride = (long)dil * 4;
            a.gate = nullptr; a.gstride = 0;
            attn_item<0>(C.lds, a, C.tid);
        } else {
            const int i2 = it - 1536, b = i2 >> 8, hh = (i2 >> 6) & 3, nb = i2 & 63;
            const long row0 = (long)b * SEQ + nb * 128;
            a.q = (const bf16_t*)(ws + WS_MQ) + row0 * 512 + hh * 128; a.qstride = 512;
            a.k = (const bf16_t*)(ws + WS_MKV) + (long)b * 256 * 1024 + hh * 128; a.kstride = 1024;
            a.v = (const bf16_t*)(ws + WS_MKV) + (long)b * 256 * 1024 + 512 + hh * 128; a.vstride = 1024; a.k_first = 0;
            a.o = (bf16_t*)(ws + WS_H) + row0 * DM + 1536 + hh * 128; a.ostride = DM; a.lse = nullptr; a.lstride = 0;
            a.gate = (const bf16_t*)(ws + WS_MR) + row0 * 512 + hh * 128; a.gstride = 512;
            attn_item<1>(C.lds, a, C.tid);
        }
    }
}

constexpr int GL_QT = 0, GL_KT = 17408, GL_KH = 34816, GL_VT = 53248, GL_AM = 90112, GL_GA = 99328, GL_TOT = 103424, GL_DV = 105472, GL_SSQ = 105984, GL_RINV = 108032, GL_KR = 108288, GL_QR = 125696;
constexpr int GL_P272 = 272, GL_P144 = 144, GL_VP = 544;
template <bool FULL>
__device__ __forceinline__ void gla_item(const Ctx& C, int item) {
    LAS unsigned char* lds = C.lds; unsigned char* ws = C.ws;
    const int tid0 = C.tid;
    const int b = item >> 7, hh = (item >> 5) & 3, sc = item & 31;
    const long row0 = (long)b * SEQ + sc * 256;
    const bf16_t* GQ = (const bf16_t*)(ws + WS_GQ); const bf16_t* GK = (const bf16_t*)(ws + WS_GK); const bf16_t* GV = (const bf16_t*)(ws + WS_GV);
    const float* GA = (const float*)(ws + WS_GA);
    f32x4 S[8][2];
    if (FULL) { const float* sp = (const float*)(ws + WS_SSTART) + (size_t)item * 32768;
        unsigned sbase = (unsigned)((4 * ((tid0 & 63) >> 4)) * 256 + 32 * (tid0 >> 6) + (tid0 & 15)); asm volatile("" : "+v"(sbase));
#pragma unroll
        for (int kt = 0; kt < 8; ++kt)
#pragma unroll
            for (int vt = 0; vt < 2; ++vt)
#pragma unroll
                for (int r = 0; r < 4; ++r) S[kt][vt][r] = sp[sbase + (unsigned)((16 * kt + r) * 256 + 16 * vt)];
    } else {
#pragma unroll
        for (int kt = 0; kt < 8; ++kt)
#pragma unroll
            for (int vt = 0; vt < 2; ++vt) S[kt][vt] = (f32x4){0.f, 0.f, 0.f, 0.f};
    }
    float bsum = 0.f;
#pragma unroll 1
    for (int ch = 0; ch < 4; ++ch) {
        const long crow = row0 + ch * 64;
        int tid = tid0; asm volatile("" : "+v"(tid));
        const int lane = tid & 63, wid = tid >> 6, h4 = lane >> 4, l15 = lane & 15, kcol = tid & 127, tg = tid >> 7;
        float wa[16]; float bia;
        { unsigned kc = (unsigned)(hh * 128 + kcol); asm volatile("" : "+v"(kc));
#pragma unroll
          for (int r = 0; r < 16; ++r) wa[r] = C.in[10][r * 512 + kc];
          bia = C.in[11][kc]; }
        const unsigned crow32 = (unsigned)crow;
        if (tid < 256) ((LAS f32x4*)(lds + GL_GA))[tid] = ((const f32x4*)(GA + (size_t)crow32 * 16))[tid];
        {
            u32x4 vv[4], kk2[2], qq2[2];
#pragma unroll
            for (int it = 0; it < 4; ++it) { const unsigned c = tid + 512 * it, s = c >> 5, cc = c & 31; vv[it] = *(const u32x4*)(GV + ((crow32 + s) * 1024u + hh * 256 + cc * 8)); }
#pragma unroll
            for (int it = 0; it < 2; ++it) { const unsigned c = tid + 512 * it, s = c >> 4, cc = c & 15; kk2[it] = *(const u32x4*)(GK + ((crow32 + s) * 512u + hh * 128 + cc * 8));
                if (FULL) qq2[it] = *(const u32x4*)(GQ + ((crow32 + s) * 512u + hh * 128 + cc * 8)); }
#pragma unroll
            for (int it = 0; it < 2; ++it) { const unsigned c = tid + 512 * it, s = c >> 4, cc = c & 15; *(LAS u32x4*)(lds + GL_KR + s * GL_P272 + cc * 16) = kk2[it];
                if (FULL) *(LAS u32x4*)(lds + GL_QR + s * GL_P272 + cc * 16) = qq2[it]; }
#pragma unroll
            for (int it = 0; it < 4; ++it) { const int c = tid + 512 * it, s = c >> 5, cc = c & 31; *(LAS u32x4*)(lds + GL_VT + s * GL_VP + cc * 16) = vv[it]; }
        }
        __syncthreads();
        float cs[16]; float run = 0.f;
#pragma unroll
        for (int i = 0; i < 16; ++i) { const LAS f32x4* gp = (const LAS f32x4*)(lds + GL_GA + (16 * tg + i) * 64); float x = bia;
#pragma unroll
            for (int q4 = 0; q4 < 4; ++q4) { const f32x4 g = gp[q4]; x += g.x * wa[4 * q4] + g.y * wa[4 * q4 + 1] + g.z * wa[4 * q4 + 2] + g.w * wa[4 * q4 + 3]; }
            const float ls = fminf(x, 0.f) - __logf(1.f + __expf(-fabsf(x)));
            run += ls * (1.f / 16.f); cs[i] = run; if ((i & 3) == 3) __builtin_amdgcn_sched_barrier(0); }
        ((LAS float*)(lds + GL_TOT))[tg * 128 + kcol] = run;
        __syncthreads();
        float off = 0.f, bend = 0.f;
#pragma unroll
        for (int g = 0; g < 4; ++g) { const float tt = ((LAS float*)(lds + GL_TOT))[g * 128 + kcol]; off += (g < tg) ? tt : 0.f; bend += tt; }
        if (tg == 0) ((LAS float*)(lds + GL_DV))[kcol] = __expf(bend);
        bsum += bend;
        { unsigned kh[8];
#pragma unroll
            for (int i = 0; i < 16; i += 2) { const float b0 = off + cs[i], b1 = off + cs[i + 1];
                const float k0 = bf2f(*(const LAS unsigned short*)(lds + GL_KR + (16 * tg + i) * GL_P272 + kcol * 2)), k1 = bf2f(*(const LAS unsigned short*)(lds + GL_KR + (16 * tg + i + 1) * GL_P272 + kcol * 2));
                kh[i >> 1] = pk2(k0 * __expf(bend - b0), k1 * __expf(bend - b1));
                if (FULL) { const float q0 = bf2f(*(const LAS unsigned short*)(lds + GL_QR + (16 * tg + i) * GL_P272 + kcol * 2)), q1 = bf2f(*(const LAS unsigned short*)(lds + GL_QR + (16 * tg + i + 1) * GL_P272 + kcol * 2));
                    *(LAS unsigned short*)(lds + GL_QT + (16 * tg + i) * GL_P272 + kcol * 2) = f2bf(q0 * __expf(b0) * QSCALE);
                    *(LAS unsigned short*)(lds + GL_QT + (16 * tg + i + 1) * GL_P272 + kcol * 2) = f2bf(q1 * __expf(b1) * QSCALE);
                    *(LAS unsigned short*)(lds + GL_KT + (16 * tg + i) * GL_P272 + kcol * 2) = f2bf(k0 * __expf(-b0));
                    *(LAS unsigned short*)(lds + GL_KT + (16 * tg + i + 1) * GL_P272 + kcol * 2) = f2bf(k1 * __expf(-b1)); } }
            LAS u32x4* kp = (LAS u32x4*)(lds + GL_KH + kcol * GL_P144 + tg * 32);
            kp[0] = (u32x4){kh[0], kh[1], kh[2], kh[3]}; kp[1] = (u32x4){kh[4], kh[5], kh[6], kh[7]}; }
        __syncthreads();
        f32x4 oacc[4][2];
        if (FULL) {
#pragma unroll
            for (int ti = 0; ti < 2; ++ti) { const int idx = 2 * wid + ti, tt = idx >> 2, st = idx & 3; f32x4 c = {0.f, 0.f, 0.f, 0.f};
                if (st <= tt) {
#pragma unroll
                    for (int ks = 0; ks < 4; ++ks) { const bf16x8 af = *(const LAS bf16x8*)(lds + GL_QT + (16 * tt + l15) * GL_P272 + (8 * h4 + 32 * ks) * 2);
                        const bf16x8 bfr = *(const LAS bf16x8*)(lds + GL_KT + (16 * st + l15) * GL_P272 + (8 * h4 + 32 * ks) * 2); c = mfma16(af, bfr, c); } }
#pragma unroll
                for (int r = 0; r < 4; ++r) { const int t = 16 * tt + 4 * h4 + r, s = 16 * st + l15;
                    *(LAS unsigned short*)(lds + GL_AM + t * GL_P144 + s * 2) = f2bf((t >= s) ? c[r] : 0.f); } }
#pragma unroll
            for (int tt = 0; tt < 4; ++tt)
#pragma unroll
                for (int vt = 0; vt < 2; ++vt) oacc[tt][vt] = (f32x4){0.f, 0.f, 0.f, 0.f};
#pragma unroll
            for (int ks = 0; ks < 4; ++ks) {
                bf16x8 sb[2];
#pragma unroll
                for (int vt = 0; vt < 2; ++vt) { const u32x4 w = {pk2(S[2 * ks][vt][0], S[2 * ks][vt][1]), pk2(S[2 * ks][vt][2], S[2 * ks][vt][3]), pk2(S[2 * ks + 1][vt][0], S[2 * ks + 1][vt][1]), pk2(S[2 * ks + 1][vt][2], S[2 * ks + 1][vt][3])};
                    sb[vt] = __builtin_bit_cast(bf16x8, w); }
#pragma unroll
                for (int tt = 0; tt < 4; ++tt) { const LAS unsigned char* qp = lds + GL_QT + (16 * tt + l15) * GL_P272 + (32 * ks + 4 * h4) * 2;
                    const u32x2 lo = *(const LAS u32x2*)qp, hi = *(const LAS u32x2*)(qp + 32); const u32x4 w = {lo.x, lo.y, hi.x, hi.y}; const bf16x8 qa = __builtin_bit_cast(bf16x8, w);
#pragma unroll
                    for (int vt = 0; vt < 2; ++vt) oacc[tt][vt] = mfma16(qa, sb[vt], oacc[tt][vt]); } }
            __syncthreads();
#pragma unroll
            for (int ks = 0; ks < 2; ++ks) {
                bf16x8 vb[2];
#pragma unroll
                for (int vt = 0; vt < 2; ++vt) { const LAS unsigned char* vp = lds + GL_VT + (32 * ks + 4 * h4 + (l15 >> 2)) * GL_VP + (32 * wid + 16 * vt + 4 * (l15 & 3)) * 2; vb[vt] = tr_pair(vp, vp + 16 * GL_VP); }
#pragma unroll
                for (int tt = 0; tt < 4; ++tt) { const LAS unsigned char* ap = lds + GL_AM + (16 * tt + l15) * GL_P144 + (32 * ks + 4 * h4) * 2;
                    const u32x2 lo = *(const LAS u32x2*)ap, hi = *(const LAS u32x2*)(ap + 32); const u32x4 w = {lo.x, lo.y, hi.x, hi.y}; const bf16x8 aa = __builtin_bit_cast(bf16x8, w);
#pragma unroll
                    for (int vt = 0; vt < 2; ++vt) oacc[tt][vt] = mfma16(aa, vb[vt], oacc[tt][vt]); } }
        }
#pragma unroll
        for (int kt = 0; kt < 8; ++kt) { const f32x4 d4 = *(const LAS f32x4*)(lds + GL_DV + (16 * kt + 4 * h4) * 4);
#pragma unroll
            for (int vt = 0; vt < 2; ++vt) S[kt][vt] = S[kt][vt] * d4; }
#pragma unroll
        for (int ks = 0; ks < 2; ++ks) {
            bf16x8 vb[2];
#pragma unroll
            for (int vt = 0; vt < 2; ++vt) { const LAS unsigned char* vp = lds + GL_VT + (32 * ks + 4 * h4 + (l15 >> 2)) * GL_VP + (32 * wid + 16 * vt + 4 * (l15 & 3)) * 2; vb[vt] = tr_pair(vp, vp + 16 * GL_VP); }
#pragma unroll
            for (int kt = 0; kt < 8; ++kt) { const LAS unsigned char* kp = lds + GL_KH + (16 * kt + l15) * GL_P144 + (32 * ks + 4 * h4) * 2;
                const u32x2 lo = *(const LAS u32x2*)kp, hi = *(const LAS u32x2*)(kp + 32); const u32x4 w = {lo.x, lo.y, hi.x, hi.y}; const bf16x8 ka = __builtin_bit_cast(bf16x8, w);
#pragma unroll
                for (int vt = 0; vt < 2; ++vt) S[kt][vt] = mfma16(ka, vb[vt], S[kt][vt]); } }
        if (FULL) {
#pragma unroll
            for (int tt = 0; tt < 4; ++tt)
#pragma unroll
                for (int r = 0; r < 4; ++r) { float ss = oacc[tt][0][r] * oacc[tt][0][r] + oacc[tt][1][r] * oacc[tt][1][r];
                    ss += __shfl_xor(ss, 1); ss += __shfl_xor(ss, 2); ss += __shfl_xor(ss, 4); ss += __shfl_xor(ss, 8);
                    if (l15 == 0) ((LAS float*)(lds + GL_SSQ))[wid * 64 + 16 * tt + 4 * h4 + r] = ss; }
            __syncthreads();
            if (tid < 64) { float tot = 0.f;
#pragma unroll
                for (int w = 0; w < 8; ++w) tot += ((LAS float*)(lds + GL_SSQ))[w * 64 + tid];
                ((LAS float*)(lds + GL_RINV))[tid] = rsqrtf(tot * (1.f / 256.f) + RMS_EPS); }
            __syncthreads();
#pragma unroll
            for (int tt = 0; tt < 4; ++tt)
#pragma unroll
                for (int r = 0; r < 4; ++r) { const int t = 16 * tt + 4 * h4 + r; const float ri = ((LAS float*)(lds + GL_RINV))[t];
#pragma unroll
                    for (int vt = 0; vt < 2; ++vt) *(LAS unsigned short*)(lds + GL_QT + t * 528 + (32 * wid + 16 * vt + l15) * 2) = f2bf(oacc[tt][vt][r] * ri); }
            __syncthreads();
            {
                const bf16_t* GR = (const bf16_t*)(ws + WS_GR); bf16_t* U = (bf16_t*)(ws + WS_H);
#pragma unroll
                for (int it = 0; it < 4; ++it) { const unsigned c = tid + 512 * it, t = c >> 5, c8 = (c & 31) * 8; const unsigned col = hh * 256 + c8;
                    const u32x4 ov = *(const LAS u32x4*)(lds + GL_QT + t * 528 + c8 * 2); const u32x4 gr = *(const u32x4*)(GR + ((crow32 + t) * 1024u + col));
                    const f32x4 g0 = *(const f32x4*)(C.in[12] + col), g1 = *(const f32x4*)(C.in[12] + col + 4);
                    u32x4 w;
                    w.x = pk2(__uint_as_float(ov.x << 16) * g0.x * __uint_as_float(gr.x << 16), __uint_as_float(ov.x & 0xffff0000u) * g0.y * __uint_as_float(gr.x & 0xffff0000u));
                    w.y = pk2(__uint_as_float(ov.y << 16) * g0.z * __uint_as_float(gr.y << 16), __uint_as_float(ov.y & 0xffff0000u) * g0.w * __uint_as_float(gr.y & 0xffff0000u));
                    w.z = pk2(__uint_as_float(ov.z << 16) * g1.x * __uint_as_float(gr.z << 16), __uint_as_float(ov.z & 0xffff0000u) * g1.y * __uint_as_float(gr.z & 0xffff0000u));
                    w.w = pk2(__uint_as_float(ov.w << 16) * g1.z * __uint_as_float(gr.w << 16), __uint_as_float(ov.w & 0xffff0000u) * g1.w * __uint_as_float(gr.w & 0xffff0000u));
                    *(u32x4*)(U + ((size_t)(crow32 + t) * DM + col)) = w; }
            }
        }
        __syncthreads();
    }
    if (!FULL) {
        float* sl = (float*)(ws + WS_SLOC) + (size_t)item * 32768;
        unsigned sbase = (unsigned)((4 * ((tid0 & 63) >> 4)) * 256 + 32 * (tid0 >> 6) + (tid0 & 15)); asm volatile("" : "+v"(sbase));
#pragma unroll
        for (int kt = 0; kt < 8; ++kt)
#pragma unroll
            for (int vt = 0; vt < 2; ++vt)
#pragma unroll
                for (int r = 0; r < 4; ++r) sl[sbase + (unsigned)((16 * kt + r) * 256 + 16 * vt)] = S[kt][vt][r];
        if (tid0 < 128) ((float*)(ws + WS_GLAD))[item * 128 + tid0] = __expf(bsum);
    }
}
__device__ __forceinline__ void gla_scan(const Ctx& C) {
    unsigned char* ws = C.ws;
    const int g = C.vcu * NTHR + C.tid;
    if (g >= 131072) return;
    const int bh = g >> 14, rem = g & 16383, dk = rem >> 7, dv = (rem & 127) * 2;
    const float* sl = (const float*)(ws + WS_SLOC) + (size_t)bh * 32 * 32768 + dk * 256 + dv;
    float* ss = (float*)(ws + WS_SSTART) + (size_t)bh * 32 * 32768 + dk * 256 + dv;
    const float* dd = (const float*)(ws + WS_GLAD) + bh * 32 * 128 + dk;
    f32x2 loc[32]; float d[32];
#pragma unroll
    for (int s = 0; s < 32; ++s) { loc[s] = *(const f32x2*)(sl + (size_t)s * 32768); d[s] = dd[s * 128]; }
    f32x2 S = {0.f, 0.f};
#pragma unroll
    for (int s = 0; s < 32; ++s) { *(f32x2*)(ss + (size_t)s * 32768) = S; S = S * d[s] + loc[s]; }
    *(f32x2*)(C.out + OFF_GLAP + (size_t)bh * 32768 + dk * 256 + dv) = S;
}

__device__ __forceinline__ void dec_gla_item(const Ctx& C, int item) {
    LAS float* L = (LAS float*)C.lds;
    unsigned char* ws = C.ws; const int tid = C.tid, s = item >> 2, hh = item & 3; const long row = MP + s;
    if (tid < 128) { const float* ga = (const float*)(ws + WS_GA) + row * 16; float x = C.in[11][hh * 128 + tid];
#pragma unroll
        for (int r = 0; r < 16; ++r) x += ga[r] * C.in[10][r * 512 + hh * 128 + tid];
        const float ls = fminf(x, 0.f) - __logf(1.f + __expf(-fabsf(x)));
        L[tid] = __expf(ls * (1.f / 16.f));
        L[128 + tid] = bf2f(((const bf16_t*)(ws + WS_GQ))[row * 512 + hh * 128 + tid]) * QSCALE;
        L[256 + tid] = bf2f(((const bf16_t*)(ws + WS_GK))[row * 512 + hh * 128 + tid]); }
    __syncthreads();
    const int dv = tid & 255, half = tid >> 8;
    const float v = bf2f(((const bf16_t*)(ws + WS_GV))[row * 1024 + hh * 256 + dv]);
    const float* sp = C.in[3] + ((size_t)(s * 4 + hh) * 128 + half * 64) * 256 + dv; float* op = C.out + OFF_GLAS + ((size_t)(s * 4 + hh) * 128 + half * 64) * 256 + dv;
    float o = 0.f;
#pragma unroll 32
    for (int i = 0; i < 64; ++i) { const int dk = half * 64 + i; const float sn = L[dk] * sp[(size_t)i * 256] + L[256 + dk] * v; op[(size_t)i * 256] = sn; o += L[128 + dk] * sn; }
    L[384 + tid] = o;
    __syncthreads();
    float ot = 0.f, ss = 0.f;
    if (tid < 256) { ot = L[384 + tid] + L[384 + 256 + tid]; ss = ot * ot; }
    ss = wave_sum(ss);
    if (C.lane == 0) L[896 + C.wave] = ss;
    __syncthreads();
    if (tid < 256) { const float tot = L[896] + L[897] + L[898] + L[899]; const float ri = rsqrtf(tot * (1.f / 256.f) + RMS_EPS); const int col = hh * 256 + tid;
        ((bf16_t*)(ws + WS_H))[row * DM + col] = f2bf(ot * ri * C.in[12][col] * bf2f(((const bf16_t*)(ws + WS_GR))[row * 1024 + col])); }
    __syncthreads();
}
__device__ __forceinline__ float dot_reduce(float q1, float q2, float k1, float k2) { return wave_sum(q1 * k1 + q2 * k2); }
__device__ __forceinline__ void dec_combine(LAS float* L, int tid, const bf16_t* gate, bf16_t* U) {
    __syncthreads();
    if (tid < 128) { float M = -1e30f;
#pragma unroll
        for (int w = 0; w < 8; ++w) M = fmaxf(M, L[w * 130 + 128]);
        float D = 0.f, O = 0.f;
#pragma unroll
        for (int w = 0; w < 8; ++w) { const float f = __expf(L[w * 130 + 128] - M); D += L[w * 130 + 129] * f; O += L[w * 130 + tid] * f; }
        U[tid] = f2bf(__fdividef(O, D) * bf2f(gate[tid])); }
    __syncthreads();
}
__device__ __forceinline__ void dec_swa_block(const Ctx& C, int item) {
    unsigned char* ws = C.ws; LAS float* L = (LAS float*)C.lds; const int lane = C.lane, w = C.wave, s = item >> 2, j = item & 3; const long row = MP + s;
    float q1[3], q2[3];
#pragma unroll
    for (int g = 0; g < 3; ++g) { const unsigned qq = *(const unsigned*)((const bf16_t*)(ws + WS_SQ) + row * 1536 + (g * 4 + j) * 128 + 2 * lane);
        q1[g] = __uint_as_float(qq << 16); q2[g] = __uint_as_float(qq & 0xffff0000u); }
    float sc = -1e30f;
#pragma unroll
    for (int g = 0; g < 3; ++g) {
        const int W = 128 << (2 * g), dil = 1 << (2 * g);
        const float* cb = C.in[4 + g] + (size_t)s * W * 1024 + j * 128 + (size_t)(W - dil * (16 * w + 1)) * 1024 + lane;
        float k1[16], k2[16];
#pragma unroll
        for (int u = 0; u < 16; ++u) { k1[u] = __builtin_nontemporal_load(cb - (size_t)(dil * u) * 1024); k2[u] = __builtin_nontemporal_load(cb - (size_t)(dil * u) * 1024 + 64); }
#pragma unroll
        for (int u = 0; u < 16; ++u) { const float d = dot_reduce(q1[g], q2[g], k1[u], k2[u]); if (lane == g * 16 + u) sc = d; }
    }
    float vn1 = 0.f, vn2 = 0.f;
    if (w < 3) { const int hg = w * 4 + j; const unsigned kk = *(const unsigned*)((const bf16_t*)(ws + WS_SK) + row * 1536 + hg * 128 + 2 * lane);
        const float qa = (w == 0) ? q1[0] : (w == 1) ? q1[1] : q1[2], qb = (w == 0) ? q2[0] : (w == 1) ? q2[1] : q2[2];
        const float d = dot_reduce(qa, qb, __uint_as_float(kk << 16), __uint_as_float(kk & 0xffff0000u)); if (lane == 48) sc = d;
        vn1 = bf2f(((const bf16_t*)(ws + WS_SV))[row * 1536 + hg * 128 + lane]); vn2 = bf2f(((const bf16_t*)(ws + WS_SV))[row * 1536 + hg * 128 + 64 + lane]); }
    const float mx = wave_max(sc); const float p = (sc > -1e29f) ? __expf(sc - mx) : 0.f; const float den = wave_sum(p);
    float o1 = 0.f, o2 = 0.f;
#pragma unroll
    for (int g = 0; g < 3; ++g) {
        const int W = 128 << (2 * g), dil = 1 << (2 * g);
        const float* cb = C.in[4 + g] + (size_t)s * W * 1024 + 512 + j * 128 + (size_t)(W - dil * (16 * w + 1)) * 1024 + lane;
        float v1[16], v2[16];
#pragma unroll
        for (int u = 0; u < 16; ++u) { v1[u] = __builtin_nontemporal_load(cb - (size_t)(dil * u) * 1024); v2[u] = __builtin_nontemporal_load(cb - (size_t)(dil * u) * 1024 + 64); }
#pragma unroll
        for (int u = 0; u < 16; ++u) { const float pu = __shfl(p, g * 16 + u); o1 += pu * v1[u]; o2 += pu * v2[u]; }
    }
    { const float pu = __shfl(p, 48); o1 += pu * vn1; o2 += pu * vn2; }
    L[w * 130 + lane] = o1; L[w * 130 + 64 + lane] = o2; if (lane == 0) { L[w * 130 + 128] = mx; L[w * 130 + 129] = den; }
    dec_combine(L, C.tid, (const bf16_t*)(ws + WS_SR) + row * 512 + j * 128, (bf16_t*)(ws + WS_H) + row * DM + 1024 + j * 128);
}
__device__ __forceinline__ void dec_mem_block(const Ctx& C, int item) {
    unsigned char* ws = C.ws; LAS float* L = (LAS float*)C.lds; const int lane = C.lane, w = C.wave, s = item >> 2, hh = item & 3; const long row = MP + s;
    const bf16_t* MQ = (const bf16_t*)(ws + WS_MQ) + row * 512 + hh * 128;
    const float q1 = bf2f(MQ[lane]), q2 = bf2f(MQ[64 + lane]);
    const float* cb = C.in[7] + (size_t)s * 256 * 1024 + hh * 128 + (size_t)(32 * w) * 1024 + lane;
    float sc = -1e30f;
#pragma unroll
    for (int it = 0; it < 2; ++it) { float k1[16], k2[16];
#pragma unroll
        for (int u = 0; u < 16; ++u) { k1[u] = __builtin_nontemporal_load(cb + (size_t)(16 * it + u) * 1024); k2[u] = __builtin_nontemporal_load(cb + (size_t)(16 * it + u) * 1024 + 64); }
#pragma unroll
        for (int u = 0; u < 16; ++u) { const float d = dot_reduce(q1, q2, k1[u], k2[u]); if (lane == 16 * it + u) sc = d; } }
    const float mx = wave_max(sc); const float p = (sc > -1e29f) ? __expf(sc - mx) : 0.f; const float den = wave_sum(p);
    float o1 = 0.f, o2 = 0.f;
#pragma unroll
    for (int it = 0; it < 2; ++it) { float v1[16], v2[16];
#pragma unroll
        for (int u = 0; u < 16; ++u) { v1[u] = __builtin_nontemporal_load(cb + 512 + (size_t)(16 * it + u) * 1024); v2[u] = __builtin_nontemporal_load(cb + 512 + (size_t)(16 * it + u) * 1024 + 64); }
#pragma unroll
        for (int u = 0; u < 16; ++u) { const float pu = __shfl(p, 16 * it + u); o1 += pu * v1[u]; o2 += pu * v2[u]; } }
    L[w * 130 + lane] = o1; L[w * 130 + 64 + lane] = o2; if (lane == 0) { L[w * 130 + 128] = mx; L[w * 130 + 129] = den; }
    dec_combine(L, C.tid, (const bf16_t*)(ws + WS_MR) + row * 512 + hh * 128, (bf16_t*)(ws + WS_H) + row * DM + 1536 + hh * 128);
}
constexpr int CP_RT = 32 * (127 + 511 + 2047);
constexpr int CP_NG = CP_RT / 8;
static_assert(CP_RT % 8 == 0, "row groups");
__device__ __forceinline__ void cache_copy(const Ctx& C, int g0, int g1, int worker, int nworkers) {
    const int sub = C.tid >> 8, t4 = C.tid & 255;
    constexpr int R0 = 32 * 127, R1 = 32 * 511;
    for (int rg = g0 + worker * 2 + sub; rg < g1; rg += nworkers * 2) {
        f32x4 v[8]; f32x4* dp[8];
#pragma unroll
        for (int u = 0; u < 8; ++u) {
            int r = rg * 8 + u, g, W;
            if (r < R0) { g = 0; W = 128; } else if (r < R0 + R1) { r -= R0; g = 1; W = 512; } else { r -= R0 + R1; g = 2; W = 2048; }
            const int s = r / (W - 1), i = r % (W - 1);
            const f32x4* src = (const f32x4*)((g == 0 ? C.in[4] : g == 1 ? C.in[5] : C.in[6]) + ((size_t)s * W + i + 1) * 1024);
            dp[u] = (f32x4*)(C.out + (g == 0 ? OFF_SWS0 : g == 1 ? OFF_SWS1 : OFF_SWS2) + ((size_t)s * W + i) * 1024) + t4;
            v[u] = __builtin_nontemporal_load(src + t4);
        }
#pragma unroll
        for (int u = 0; u < 8; ++u) __builtin_nontemporal_store(v[u], dp[u]);
    }
}
__device__ __forceinline__ void p3_swa_combine(const Ctx& C) {
    unsigned char* ws = C.ws;
    const bf16_t* OB = (const bf16_t*)(ws + WS_OB); const float* LSE = (const float*)(ws + WS_LSE); const bf16_t* SR = (const bf16_t*)(ws + WS_SR); bf16_t* U = (bf16_t*)(ws + WS_H);
    for (int i = C.vcu * NTHR + C.tid; i < MP * 64; i += C.G * NTHR) {
        const int row = i >> 6, c8 = (i & 63) * 8, jh = c8 >> 7;
        const float l0 = LSE[(size_t)row * 4 + jh], l1 = LSE[(size_t)MP * 4 + (size_t)row * 4 + jh], l2 = LSE[(size_t)2 * MP * 4 + (size_t)row * 4 + jh];
        const float mx = fmaxf(l0, fmaxf(l1, l2)); float w0 = __expf(l0 - mx), w1 = __expf(l1 - mx), w2 = __expf(l2 - mx); const float ri = __fdividef(1.f, w0 + w1 + w2); w0 *= ri; w1 *= ri; w2 *= ri;
        const u32x4 a = *(const u32x4*)(OB + (size_t)row * 512 + c8), b = *(const u32x4*)(OB + (size_t)MP * 512 + (size_t)row * 512 + c8), c = *(const u32x4*)(OB + (size_t)2 * MP * 512 + (size_t)row * 512 + c8);
        const u32x4 g = *(const u32x4*)(SR + (size_t)row * 512 + c8);
        u32x4 o;
#define CMB(f) { const float lo = (w0 * __uint_as_float(a.f << 16) + w1 * __uint_as_float(b.f << 16) + w2 * __uint_as_float(c.f << 16)) * __uint_as_float(g.f << 16); \
                 const float hi = (w0 * __uint_as_float(a.f & 0xffff0000u) + w1 * __uint_as_float(b.f & 0xffff0000u) + w2 * __uint_as_float(c.f & 0xffff0000u)) * __uint_as_float(g.f & 0xffff0000u); o.f = pk2(lo, hi); }
        CMB(x) CMB(y) CMB(z) CMB(w)
#undef CMB
        *(u32x4*)(U + (size_t)row * DM + 1024 + c8) = o;
    }
}
constexpr size_t WS_ROWSS_S = WS_ROWSS + 2621440;
__device__ __forceinline__ void skinny_partial(LAS float* L, const bf16_t* A, const bf16_t* Bt, int n0, int w, int lane) {
    const int h = lane >> 4, l15 = lane & 15;
    f32x4 acc[2] = {{0.f, 0.f, 0.f, 0.f}, {0.f, 0.f, 0.f, 0.f}};
    const bf16_t* ap = A + (size_t)(MP + l15) * DM + 256 * w + 8 * h; const bf16_t* bp = Bt + (size_t)(n0 + l15) * DM + 256 * w + 8 * h;
    bf16x8 a0[8], a1[8], b[8];
#pragma unroll
    for (int ks = 0; ks < 8; ++ks) { a0[ks] = *(const bf16x8*)(ap + 32 * ks); a1[ks] = *(const bf16x8*)(ap + 16 * DM + 32 * ks); b[ks] = *(const bf16x8*)(bp + 32 * ks); }
#pragma unroll
    for (int ks = 0; ks < 8; ++ks) { acc[0] = mfma16(a0[ks], b[ks], acc[0]); acc[1] = mfma16(a1[ks], b[ks], acc[1]); }
#pragma unroll
    for (int rt = 0; rt < 2; ++rt)
#pragma unroll
        for (int r = 0; r < 4; ++r) L[w * 512 + (16 * rt + 4 * h + r) * 16 + l15] = acc[rt][r];
}
__device__ __forceinline__ void skinny_mid_item(const Ctx& C, int item) {
    LAS float* L = (LAS float*)C.lds; unsigned char* ws = C.ws; const int n0 = 16 * item, tid = C.tid;
    skinny_partial(L, (const bf16_t*)(ws + WS_H), (const bf16_t*)(ws + WS_WTMID), n0, C.wave, C.lane);
    __syncthreads();
    { const int row = tid >> 4, col = tid & 15; const float ya = (L[tid] + L[512 + tid]) + (L[1024 + tid] + L[1536 + tid]), yb = L[2048 + tid] + L[2560 + tid], yc = L[3072 + tid] + L[3584 + tid];
      const bf16_t* gp = (const bf16_t*)(ws + WS_GT) + (size_t)(MP + row) * 6144 + n0 + col;
      ((bf16_t*)(ws + WS_MERGED))[(size_t)(MP + row) * DM + n0 + col] = f2bf(bf2f(gp[0]) * ya + bf2f(gp[2048]) * yb + bf2f(gp[4096]) * yc); }
    __syncthreads();
}
__device__ __forceinline__ void skinny_out_item(const Ctx& C, int item) {
    LAS float* L = (LAS float*)C.lds; unsigned char* ws = C.ws; const int n0 = 16 * item, tid = C.tid;
    skinny_partial(L, (const bf16_t*)(ws + WS_MERGED), (const bf16_t*)(ws + WS_WTOUT), n0, C.wave, C.lane);
    __syncthreads();
    { const int row = tid >> 4, col = tid & 15; float y = 0.f;
#pragma unroll
      for (int w = 0; w < 8; ++w) y += L[w * 512 + tid];
      const float v = C.in[1][(size_t)row * DM + n0 + col] + y; C.out[OFF_YS + (size_t)row * DM + n0 + col] = v;
      float ss = v * v; ss += __shfl_xor(ss, 1); ss += __shfl_xor(ss, 2); ss += __shfl_xor(ss, 4); ss += __shfl_xor(ss, 8);
      if (col == 0) ((float*)(ws + WS_ROWSS_S))[row * 128 + item] = ss; }
    __syncthreads();
}
__device__ __forceinline__ void p7_final_norm(const Ctx& C) {
    const float* rowss = (const float*)(C.ws + WS_ROWSS); const f32x4* gf = (const f32x4*)C.in[19] + C.lane;
    const int gw = C.vcu * NWAVES + C.wave, NGW = C.G * NWAVES;
    for (int r = gw; r < MP + MS; r += NGW) {
        float ss;
        if (r < MP) ss = (C.lane < 32) ? rowss[(size_t)r * 32 + C.lane] : 0.f;
        else { const float* rs = (const float*)(C.ws + WS_ROWSS_S) + (r - MP) * 128; ss = rs[C.lane] + rs[64 + C.lane]; }
        ss = wave_sum(ss);
        const float ri = rsqrtf(ss * (1.f / DM) + RMS_EPS);
        f32x4* y = (f32x4*)((r < MP) ? C.out + OFF_YP + (size_t)r * DM : C.out + OFF_YS + (size_t)(r - MP) * DM) + C.lane;
        f32x4 v[8];
#pragma unroll
        for (int j = 0; j < 8; ++j) v[j] = y[64 * j];
#pragma unroll
        for (int j = 0; j < 8; ++j) y[64 * j] = v[j] * ri * gf[64 * j];
    }
}

#ifndef MK_N_LAUNCHES
#define MK_N_LAUNCHES 1
#endif
constexpr int N_PHASES = 8;
constexpr int CP_G1 = 123 * 36;
__global__ void __launch_bounds__(NTHR, 2) fwd_kernel(Params P) {
    extern __shared__ __attribute__((aligned(16))) unsigned char lds_raw[];
    Ctx C;
    C.lds = (LAS unsigned char*)lds_raw;
    C.tid = threadIdx.x; C.lane = C.tid & 63; C.wave = __builtin_amdgcn_readfirstlane(C.tid >> 6);
    C.G = gridDim.x; { const int bx = blockIdx.x; C.vcu = (C.G % 8 == 0) ? (bx % 8) * (C.G / 8) + bx / 8 : bx; }
    C.in = P.in; C.out = P.out; C.ws = P.ws;
    volatile LAS unsigned* MISC = (volatile LAS unsigned*)(C.lds + MISC_OFF);
    if (C.tid < 64) MISC[C.tid] = 0u;
    __syncthreads();
    const int lo = P.ph_lo, hi = P.ph_hi;
    unsigned* barw = (unsigned*)(C.ws + WS_CTL) + CW_BAR + (lo == 0 ? 0 : XCD_BAR_WORDS);
    XcdBarrier bar; bar.bar = barw; bar.x = 0; bar.st = nullptr;
    if (hi - lo > 1) bar = xcd_barrier_post(barw, MISC + 8);
#ifndef PH_MASK
#define PH_MASK 0xFF
#endif
#define IN(k) (((PH_MASK >> (k)) & 1) && lo <= (k) && (k) < hi)
#define SEAM(k) do { if (IN(k) && IN((k) + 1)) xcd_barrier(bar); FRESH(); } while (0)
#define FRESH() do { int t_ = threadIdx.x; asm volatile("" : "+v"(t_)); C.tid = t_; C.lane = t_ & 63; C.wave = __builtin_amdgcn_readfirstlane(t_ >> 6); } while (0)

    if (IN(0)) { p0_prep(C); }
    SEAM(0);
    if (IN(1)) {
        { pg8::Gemm g{(const bf16_t*)(C.ws + WS_H), (const bf16_t*)(C.ws + WS_WTIN), MT, NIN, DM}; pg8::StaticOrder S; S.init(MT, NIN, C.G, (int)blockIdx.x);
          EpiIn E{C.ws, C.out};
          pg8::gemm_phase<EpiIn, pg8::StaticOrder, true, true>(C.lds, g, S, E); }
        { pg8::Gemm g{(const bf16_t*)(C.ws + WS_MEMH), (const bf16_t*)(C.ws + WS_WTMEM), 512, 1024, DM}; ShiftOrder S; S.init2(512, 1024, C.G, (int)blockIdx.x, C.G / 2);
          EpiMem E{C.out + OFF_MEMKV, (bf16_t*)(C.ws + WS_MKV)};
          pg8::gemm_phase<EpiMem, ShiftOrder, true, true>(C.lds, g, S, E); }
        { const int c = (int)blockIdx.x, first = (MT / 256) * (NIN / 256) - 15 * C.G;
          if (C.G == 256 && c >= first && !(c >= 128 && c < 136)) { const int wk = (c < 128) ? c - first : c - first - 8; cache_copy(C, 0, CP_G1, wk, 256 - first - 8); } }
    }
    SEAM(1);
    if (IN(2)) {
#ifndef P2_MASK
#define P2_MASK 0xFF
#endif
        if (P2_MASK & 1) for (int it = C.vcu; it < 256; it += C.G) gla_item<false>(C, it);
        if (P2_MASK & 2) p2_attention(C);
        if (P2_MASK & 4) for (int it = C.vcu; it < 128; it += C.G) dec_gla_item(C, it);
        for (int it = (C.vcu + C.G / 2) % C.G; it < 256; it += C.G) { if (it < 128) { if (P2_MASK & 8) dec_swa_block(C, it); } else { if (P2_MASK & 16) dec_mem_block(C, it - 128); } }
        if (P2_MASK & 32) cache_copy(C, CP_G1, CP_NG, C.vcu, C.G);
    }
    SEAM(2);
    if (IN(3)) { gla_scan(C); p3_swa_combine(C); }
    SEAM(3);
    if (IN(4)) { for (int it = C.vcu; it < 256; it += C.G) gla_item<true>(C, it); }
    SEAM(4);
    if (IN(5)) {
        for (int it = C.vcu; it < 128; it += C.G) skinny_mid_item(C, it);
        pg8::Gemm g{(const bf16_t*)(C.ws + WS_H), (const bf16_t*)(C.ws + WS_WTMID), MP, DM, DM}; pg8::StaticOrder S; S.init(MP, DM, C.G, (int)blockIdx.x);
        EpiMid E{(const bf16_t*)(C.ws + WS_GT), (bf16_t*)(C.ws + WS_MERGED)};
        pg8::gemm_phase<EpiMid, pg8::StaticOrder, true, true>(C.lds, g, S, E);
    }
    SEAM(5);
    if (IN(6)) {
        for (int it = C.vcu; it < 128; it += C.G) skinny_out_item(C, it);
        pg8::Gemm g{(const bf16_t*)(C.ws + WS_MERGED), (const bf16_t*)(C.ws + WS_WTOUT), MP, DM, DM}; pg8::StaticOrder S; S.init(MP, DM, C.G, (int)blockIdx.x);
        EpiOut E{C.in[0], C.in[1], C.out, (float*)(C.ws + WS_ROWSS)};
        pg8::gemm_phase<EpiOut, pg8::StaticOrder, true, true>(C.lds, g, S, E);
    }
    SEAM(6);
    if (IN(7)) { p7_final_norm(C); }
#undef IN
#undef SEAM
}

extern "C" void kernel_launch(void* const* d_in, const int* in_sizes, int n_in, void* d_out, int out_size, void* d_ws, size_t ws_size, hipStream_t stream) {
    static int grid = 0;
    if (grid == 0) {
        if (n_in != 20 || in_sizes[0] != MP * DM || (size_t)out_size != OUT_TOTAL || ws_size < WS_END) {
            fprintf(stderr, "kernel_launch: unexpected shapes: n_in %d in0 %d out %d ws %zu (need %zu); nothing launched\n", n_in, n_in > 0 ? in_sizes[0] : -1, out_size, ws_size, (size_t)WS_END); grid = -1; return; }
        int dev = 0, cus = 0, per_cu = 0;
        if (hipGetDevice(&dev) != hipSuccess || hipDeviceGetAttribute(&cus, hipDeviceAttributeMultiprocessorCount, dev) != hipSuccess) { fprintf(stderr, "kernel_launch: device query failed\n"); grid = -1; return; }
        if (hipFuncSetAttribute((const void*)fwd_kernel, hipFuncAttributeMaxDynamicSharedMemorySize, LDS_BYTES) != hipSuccess) { fprintf(stderr, "kernel_launch: hipFuncSetAttribute failed\n"); grid = -1; return; }
        if (hipOccupancyMaxActiveBlocksPerMultiprocessor(&per_cu, (const void*)fwd_kernel, NTHR, LDS_BYTES) != hipSuccess || per_cu < 1) { fprintf(stderr, "kernel_launch: occupancy query says %d workgroups per CU\n", per_cu); per_cu = 1; }
        (void)hipGetLastError();
        grid = cus;
        fprintf(stderr, "kernel_launch: grid %d (occupancy query %d per CU)\n", grid, per_cu);
    }
    if (grid < 0) return;
    if (hipMemsetAsync((char*)d_ws + WS_CTL, 0, CTL_ZERO_BYTES, stream) != hipSuccess) { fprintf(stderr, "kernel_launch: memset failed\n"); return; }
    Params p{};
    for (int i = 0; i < 20; ++i) p.in[i] = (const float*)d_in[i];
    p.out = (float*)d_out; p.ws = (unsigned char*)d_ws;
#if defined(MK_PROBE)
    p.ph_lo = 0; p.ph_hi = MK_PROBE + 1; hipLaunchKernelGGL(fwd_kernel, dim3(grid), dim3(NTHR), LDS_BYTES, stream, p);
    p.ph_lo = MK_PROBE; p.ph_hi = N_PHASES; hipLaunchKernelGGL(fwd_kernel, dim3(grid), dim3(NTHR), LDS_BYTES, stream, p);
#elif MK_N_LAUNCHES == 1
    p.ph_lo = 0; p.ph_hi = N_PHASES;
    hipLaunchKernelGGL(fwd_kernel, dim3(grid), dim3(NTHR), LDS_BYTES, stream, p);
#else
    for (int k = 0; k < N_PHASES; ++k) { p.ph_lo = k; p.ph_hi = k + 1; hipLaunchKernelGGL(fwd_kernel, dim3(grid), dim3(NTHR), LDS_BYTES, stream, p); }
#endif
    const hipError_t le = hipPeekAtLastError();
    if (le != hipSuccess) fprintf(stderr, "kernel_launch: launch failed: %s\n", hipGetErrorName(le));
}
```
